# Optimizing an MI355X kernel written in HIP

```python
import jax, jax.numpy as jnp
from jax import lax
import numpy as np

D_MODEL = 2048
BATCH = 4
SEQ = 4096
DEPTH = 2

HEAD_DIM = 128
N_HEADS_SB = 8
N_HEADS_FOX = 8
WIDTH_SB = N_HEADS_SB * HEAD_DIM
WIDTH_FOX = N_HEADS_FOX * HEAD_DIM
Q_BLOCK = 128
PEER_HEADS = 8
PEER_KEYS = 128
PEER_TOPK = 16
PEER_HALF = 128
PEER_QDIM = 2 * PEER_HALF
N_EXPERTS = PEER_KEYS * PEER_KEYS
TOKEN_CHUNK = 128
PLE_DIM = 256
EPS = 1e-6

IN_SIZES = [WIDTH_SB, WIDTH_SB, WIDTH_SB,
            WIDTH_FOX, WIDTH_FOX, WIDTH_FOX,
            N_HEADS_FOX,
            D_MODEL, D_MODEL]
IN_COLS = sum(IN_SIZES)
IN_SPLITS = [int(c) for c in np.cumsum(IN_SIZES)[:-1]]

kernel_name = "hybrid_sb_fox_peer_ple"


def _rmsnorm(t, g):
    t32 = t.astype(jnp.float32)
    y = t32 * lax.rsqrt(jnp.mean(t32 * t32, axis=-1, keepdims=True) + EPS)
    return (y * g.astype(jnp.float32)).astype(t.dtype)


def _heads(t, n_heads):
    b, s, _ = t.shape
    return t.reshape(b, s, n_heads, HEAD_DIM).transpose(0, 2, 1, 3)


def _blocks(t):
    b, h, s = t.shape[:3]
    t = t.reshape(b, h, s // Q_BLOCK, Q_BLOCK, *t.shape[3:])
    return jnp.moveaxis(t, 2, 0)


def _unblocks(o):
    nb, b, h, q, hd = o.shape
    return o.transpose(1, 0, 3, 2, 4).reshape(b, nb * q, h * hd)


def stick_breaking_attention(q, k, v):
    s_len = q.shape[2]
    scale = HEAD_DIM ** -0.5
    k32 = k.astype(jnp.float32)
    v32 = v.astype(jnp.float32)
    spos = jnp.arange(s_len)

    def block(args):
        qb, start = args
        z = jnp.einsum('bhqd,bhkd->bhqk', qb.astype(jnp.float32), k32) * scale
        tpos = start + jnp.arange(Q_BLOCK)
        strict = spos[None, :] < tpos[:, None]
        log_1m = jnp.where(strict, jax.nn.log_sigmoid(-z), 0.0)
        after = lax.cumsum(log_1m, axis=3, reverse=True) - log_1m
        a = jnp.where(strict, jnp.exp(jax.nn.log_sigmoid(z) + after), 0.0)
        return jnp.einsum('bhqk,bhkd->bhqd', a, v32)

    starts = jnp.arange(s_len // Q_BLOCK, dtype=jnp.int32) * Q_BLOCK
    o = lax.map(block, (_blocks(q), starts))
    return _unblocks(o).astype(v.dtype)


def forgetting_attention(q, k, v, log_f):
    s_len = q.shape[2]
    scale = HEAD_DIM ** -0.5
    k32 = k.astype(jnp.float32)
    v32 = v.astype(jnp.float32)
    f_cum = jnp.cumsum(log_f, axis=2)
    spos = jnp.arange(s_len)

    def block(args):
        qb, fq, start = args
        z = (jnp.einsum('bhqd,bhkd->bhqk', qb.astype(jnp.float32), k32) * scale
             + fq[..., :, None] - f_cum[:, :, None, :])
        tpos = start + jnp.arange(Q_BLOCK)
        causal = spos[None, :] <= tpos[:, None]
        w = jax.nn.softmax(jnp.where(causal, z, -jnp.inf), axis=-1)
        return jnp.einsum('bhqk,bhkd->bhqd', w, v32)

    starts = jnp.arange(s_len // Q_BLOCK, dtype=jnp.int32) * Q_BLOCK
    o = lax.map(block, (_blocks(q), _blocks(f_cum), starts))
    return _unblocks(o).astype(v.dtype)


def peer_ffn(xn, w_query, sub_keys, expert_u, expert_v):
    b, s, d = xn.shape
    q = (xn @ w_query).astype(jnp.float32).reshape(b, s, PEER_HEADS, 2, PEER_HALF)
    scores = jnp.einsum('bshpc,hpkc->bshpk', q, sub_keys.astype(jnp.float32))
    s1, i1 = lax.top_k(scores[..., 0, :], PEER_TOPK)
    s2, i2 = lax.top_k(scores[..., 1, :], PEER_TOPK)
    cand_s = (s1[..., :, None] + s2[..., None, :]).reshape(b, s, PEER_HEADS, PEER_TOPK * PEER_TOPK)
    cand_i = (i1[..., :, None] * PEER_KEYS + i2[..., None, :]).reshape(b, s, PEER_HEADS, PEER_TOPK * PEER_TOPK)
    top_s, pos = lax.top_k(cand_s, PEER_TOPK)
    idx = jnp.take_along_axis(cand_i, pos, axis=-1)
    gate = jax.nn.softmax(top_s, axis=-1).astype(xn.dtype)

    n_chunks = (b * s) // TOKEN_CHUNK
    xc = xn.reshape(n_chunks, TOKEN_CHUNK, d)
    ic = idx.reshape(n_chunks, TOKEN_CHUNK, PEER_HEADS, PEER_TOPK)
    gc = gate.reshape(n_chunks, TOKEN_CHUNK, PEER_HEADS, PEER_TOPK)

    def chunk(args):
        xb, ib, gb = args
        hidden = jax.nn.gelu(jnp.einsum('chkd,cd->chk', expert_u[ib], xb), approximate=False)
        return jnp.einsum('chk,chkd->cd', gb * hidden, expert_v[ib])

    out = lax.map(chunk, (xc, ic, gc))
    return out.reshape(b, s, d)


def setup_inputs(seed: int = 0) -> dict:
    key = jax.random.key(seed)
    ks = jax.random.split(key, 20)

    def nrm(k, shape, scale):
        return jax.random.normal(k, shape, jnp.float32) * scale

    return {
        "x": nrm(ks[0], (BATCH, SEQ, D_MODEL), 1.0),
        "p": nrm(ks[1], (DEPTH, BATCH, SEQ, PLE_DIM), 1.0),
        "norm_mix_g": 1.0 + nrm(ks[2], (DEPTH, D_MODEL), 0.02),
        "w_in": nrm(ks[3], (DEPTH, D_MODEL, IN_COLS), D_MODEL ** -0.5),
        "b_forget": jnp.linspace(1.0, 5.0, N_HEADS_FOX, dtype=jnp.float32)[None, :]
                    + nrm(ks[4], (DEPTH, N_HEADS_FOX), 0.1),
        "w_branch_sb": nrm(ks[5], (DEPTH, WIDTH_SB, D_MODEL), WIDTH_SB ** -0.5),
        "w_branch_fox": nrm(ks[6], (DEPTH, WIDTH_FOX, D_MODEL), WIDTH_FOX ** -0.5),
        "w_out": nrm(ks[7], (DEPTH, D_MODEL, D_MODEL), D_MODEL ** -0.5),
        "norm_ffn_g": 1.0 + nrm(ks[8], (DEPTH, D_MODEL), 0.02),
        "w_query": nrm(ks[9], (DEPTH, D_MODEL, PEER_HEADS * PEER_QDIM), D_MODEL ** -0.5),
        "sub_keys": nrm(ks[10], (DEPTH, PEER_HEADS, 2, PEER_KEYS, PEER_HALF), PEER_HALF ** -0.5),
        "expert_u": nrm(ks[11], (DEPTH, N_EXPERTS, D_MODEL), D_MODEL ** -0.5),
        "expert_v": nrm(ks[12], (DEPTH, N_EXPERTS, D_MODEL), (PEER_HEADS * PEER_TOPK) ** -0.5),
        "norm_ple_g": 1.0 + nrm(ks[13], (DEPTH, D_MODEL), 0.02),
        "w_ple": nrm(ks[14], (DEPTH, PLE_DIM, D_MODEL), PLE_DIM ** -0.5),
        "w_ple_gate": nrm(ks[15], (DEPTH, D_MODEL, D_MODEL), D_MODEL ** -0.5),
        "final_norm_g": 1.0 + nrm(ks[16], (D_MODEL,), 0.02),
    }


def reference(x, p, norm_mix_g, w_in, b_forget, w_branch_sb, w_branch_fox, w_out,
              norm_ffn_g, w_query, sub_keys, expert_u, expert_v,
              norm_ple_g, w_ple, w_ple_gate, final_norm_g):
    h = x
    for i in range(DEPTH):
        xn = _rmsnorm(h, norm_mix_g[i])
        proj = xn @ w_in[i]
        q_sb, k_sb, v_sb, q_fx, k_fx, v_fx, f_logit, g_sb, g_fx = jnp.split(proj, IN_SPLITS, axis=-1)

        o_sb = stick_breaking_attention(_heads(q_sb, N_HEADS_SB), _heads(k_sb, N_HEADS_SB),
                                        _heads(v_sb, N_HEADS_SB))
        log_f = jax.nn.log_sigmoid(f_logit.astype(jnp.float32)
                                   + b_forget[i].astype(jnp.float32)).transpose(0, 2, 1)
        o_fx = forgetting_attention(_heads(q_fx, N_HEADS_FOX), _heads(k_fx, N_HEADS_FOX),
                                    _heads(v_fx, N_HEADS_FOX), log_f)

        merged = (jax.nn.sigmoid(g_sb) * (o_sb @ w_branch_sb[i])
                  + jax.nn.sigmoid(g_fx) * (o_fx @ w_branch_fox[i]))
        h = h + merged @ w_out[i]

        h = h + peer_ffn(_rmsnorm(h, norm_ffn_g[i]), w_query[i], sub_keys[i], expert_u[i], expert_v[i])

        ple_gate = jax.nn.sigmoid(_rmsnorm(h, norm_ple_g[i]) @ w_ple_gate[i])
        h = h + ple_gate * (p[i] @ w_ple[i])
    return _rmsnorm(h, final_norm_g)
```

```cpp
#include <hip/hip_runtime.h>
#include <hip/hip_cooperative_groups.h>
#include <cstdio>
#include <cstdint>
namespace cg = cooperative_groups;

#ifndef MK_SPLIT
#define MK_SPLIT 0
#endif

#define LAS __attribute__((address_space(3)))
typedef unsigned short bf16_t;
typedef short bf16x8 __attribute__((ext_vector_type(8)));
typedef float f32x4 __attribute__((ext_vector_type(4)));
typedef float f32x16 __attribute__((ext_vector_type(16)));
typedef unsigned u32x4 __attribute__((ext_vector_type(4)));
typedef unsigned u32x2 __attribute__((ext_vector_type(2)));
typedef __bf16 bf16v2 __attribute__((ext_vector_type(2)));
typedef float f32x2 __attribute__((ext_vector_type(2)));
typedef float v16f __attribute__((ext_vector_type(16)));
typedef float v32f __attribute__((ext_vector_type(32)));
typedef unsigned v6u __attribute__((ext_vector_type(6)));
#ifndef PEER_FP4
#define PEER_FP4 1
#endif
constexpr int ROWB = PEER_FP4 ? 1024 : 1536;

constexpr int M = 16384, DM = 2048, SEQ = 4096, NB = 4, NH = 8, HD = 128, DEPTH = 2;
constexpr int INC = 10248;
constexpr int PLE = 256;
constexpr int NEXP = 16384;
constexpr float LOG2E = 1.4426950408889634f;
constexpr float QSCALE = 0.08838834764831845f * 1.4426950408889634f;
constexpr float EPS = 1e-6f;
constexpr int NWAVES = 8, NTHREADS = 512;
constexpr int LDS_BYTES = 147456;

__device__ __forceinline__ unsigned cvt_pk_bf16(float lo, float hi) { unsigned r; asm volatile("v_cvt_pk_bf16_f32 %0, %1, %2" : "=v"(r) : "v"(lo), "v"(hi)); return r; }
__device__ __forceinline__ u32x4 pack8(f32x4 a, f32x4 b) { u32x4 w; w.x = cvt_pk_bf16(a[0], a[1]); w.y = cvt_pk_bf16(a[2], a[3]); w.z = cvt_pk_bf16(b[0], b[1]); w.w = cvt_pk_bf16(b[2], b[3]); return w; }
__device__ __forceinline__ float bflo(unsigned w) { return __builtin_bit_cast(float, w << 16); }
__device__ __forceinline__ float bfhi(unsigned w) { return __builtin_bit_cast(float, w & 0xffff0000u); }
__device__ __forceinline__ float sigmoidf_(float x) { return __builtin_amdgcn_rcpf(1.f + __builtin_amdgcn_exp2f(-x * LOG2E)); }
__device__ __forceinline__ float wave_sum(float v) {
#pragma unroll
    for (int o = 1; o < 64; o <<= 1) v += __shfl_xor(v, o);
    return v;
}

namespace pg8 {
constexpr int BM = 256, BK = 64, HALF = 128, HTB = HALF * BK * 2, STAGE_BYTES = 8 * HTB, NXCD = 8, WGM = 8;
__host__ __device__ __forceinline__ int lds_byte(int r, int c) { const int st = (r >> 4) * 2 + (c >> 5), rr = r & 15, cc = c & 31, ob = rr * 64 + cc * 2; return st * 1024 + (ob ^ (((ob >> 9) & 1) << 5)); }
__host__ __device__ __forceinline__ void stage_rc(int b, int& R, int& C) { const int st = b / 1024, sb = b % 1024, swz = sb ^ (((sb >> 9) & 1) << 5); R = (st >> 1) * 16 + swz / 64; C = (st & 1) * 32 + (swz % 64) / 2; }
__host__ __device__ __forceinline__ int perm32(int rho) { const int n = rho >> 4, i = rho & 15; return 8 * (i >> 2) + 4 * n + (i & 3); }

struct Unit { int pm, pn, aux; const char* a; const char* b; };
struct Tiles {
    int nM, nN, nwg, G, c;
    __device__ void init(int nM_, int nN_, int G_, int c_) { nM = nM_; nN = nN_; nwg = nM * nN; G = G_; c = c_; }
    __device__ bool tile(int i, int& pm, int& pn) const {
        const long L = (long)i * G + c; if (L >= nwg) return false;
        int wgid = (int)L; { const int q = nwg / NXCD, r = nwg % NXCD, xcd = wgid % NXCD, off = wgid / NXCD; wgid = (xcd < r ? xcd * (q + 1) : r * (q + 1) + (xcd - r) * q) + off; }
        const int nig = WGM * nN, gid = wgid / nig, fm = gid * WGM, gsz = (nM - fm) < WGM ? (nM - fm) : WGM;
        pm = fm + ((wgid % nig) % gsz); pn = (wgid % nig) / gsz; return true;
    }
};

template <class Epi, class Sched>
__device__ __forceinline__ void gemm_phase(LAS unsigned char* lds, const int lda, const int ldb, const int K, const Sched& S, const Epi& E) {
    int tid = threadIdx.x; asm volatile("" : "+v"(tid));
    const int wid = __builtin_amdgcn_readfirstlane(tid >> 6), lane = tid & 63, wr = wid >> 2, wc = wid & 3, fr = lane & 15, fq = lane >> 4;
    int Kv = K; asm volatile("" : "+s"(Kv));
    const int nt = Kv / BK;
    unsigned voffA[2], voffB[2];
#pragma unroll
    for (int i = 0; i < 2; ++i) { int R, C; stage_rc(tid * 16 + i * 8192, R, C); const int Rb = (R & ~31) + perm32(R & 31);
        voffA[i] = (unsigned)(R * lda + C) * 2u; voffB[i] = (unsigned)(Rb * ldb + C) * 2u; }
    const size_t kstep = (size_t)(BK * 2);
    const size_t hstepA = (size_t)HALF * lda * 2, hstepB = (size_t)HALF * ldb * 2;
    const unsigned ldsw = (unsigned)wid * 1024u;
    const int aoff = lds_byte(wr * 64 + fr, fq * 8), boff = lds_byte(wc * 32 + fr, fq * 8);
#define PG8_SA(b, h) (((b) * 2 + (h)) * HTB)
#define PG8_SB(b, h) ((4 + (b) * 2 + (h)) * HTB)
#define PG8_STAGE(bufoff, gbase, voff) do { _Pragma("unroll") for (int _i = 0; _i < 2; ++_i) \
        __builtin_amdgcn_global_load_lds((const unsigned*)((const char*)(gbase) + (voff)[_i]), (LAS unsigned*)(lds + (bufoff) + ldsw + _i * 8192), 16, 0, 0); } while (0)
#define PG8_LDA(dst, b, h) do { _Pragma("unroll") for (int m = 0; m < 4; ++m) _Pragma("unroll") for (int k = 0; k < 2; ++k) dst[m][k] = *(const LAS bf16x8*)(lds + PG8_SA(b, h) + aoff + m * 2048 + k * 1024); } while (0)
#define PG8_LDB(dst, b, h) do { _Pragma("unroll") for (int n = 0; n < 2; ++n) _Pragma("unroll") for (int k = 0; k < 2; ++k) dst[n][k] = *(const LAS bf16x8*)(lds + PG8_SB(b, h) + boff + n * 2048 + k * 1024); } while (0)
#define PG8_MMA(ai, bj, At, Bt) do { __builtin_amdgcn_s_setprio(1); _Pragma("unroll") for (int m = 0; m < 4; ++m) _Pragma("unroll") for (int n = 0; n < 2; ++n) _Pragma("unroll") for (int k = 0; k < 2; ++k) \
        acc[ai][bj][m][n] = __builtin_amdgcn_mfma_f32_16x16x32_bf16(Bt[n][k], At[m][k], acc[ai][bj][m][n], 0, 0, 0); __builtin_amdgcn_s_setprio(0); } while (0)
#define PG8_WAIT_V(n) asm volatile("s_waitcnt vmcnt(" #n ")" ::: "memory")
#define PG8_WAIT_L(n) asm volatile("s_waitcnt lgkmcnt(" #n ")" ::: "memory")
#define PG8_BAR __builtin_amdgcn_s_barrier()
#define PG8_SCHED __builtin_amdgcn_sched_barrier(0)
    Unit cur, nxt; int ui = 0;
    if (!S.next(0, cur)) return;
    f32x4 acc[2][2][4][2];
#pragma unroll
    for (int a = 0; a < 2; ++a)
#pragma unroll
        for (int b = 0; b < 2; ++b)
#pragma unroll
            for (int m = 0; m < 4; ++m)
#pragma unroll
                for (int n = 0; n < 2; ++n) acc[a][b][m][n] = (f32x4){0.f, 0.f, 0.f, 0.f};
    bf16x8 At[4][2], B0[2][2], B1[2][2];
    const char* cA = cur.a; const char* cB = cur.b;
    PG8_STAGE(PG8_SB(0, 0), cB, voffB); PG8_STAGE(PG8_SB(0, 1), cB + hstepB, voffB); PG8_STAGE(PG8_SA(0, 0), cA, voffA); PG8_STAGE(PG8_SA(0, 1), cA + hstepA, voffA);
    if (wr == 1) PG8_BAR;
    PG8_WAIT_V(2); PG8_BAR;
    PG8_STAGE(PG8_SB(1, 0), cB + kstep, voffB); PG8_STAGE(PG8_SA(1, 0), cA + kstep, voffA); PG8_STAGE(PG8_SB(1, 1), cB + hstepB + kstep, voffB);
    PG8_WAIT_V(6); PG8_BAR;
    for (;;) {
        const bool has_next = S.next(ui + 1, nxt);
        const char* nA = has_next ? nxt.a : cA; const char* nB = has_next ? nxt.b : cB;
        for (int t = 0; t < nt; t += 2) {
            const bool last = (t == nt - 2);
            const char* a1 = cA + (size_t)(t + 1) * kstep;
            const char* a2 = last ? nA : cA + (size_t)(t + 2) * kstep; const char* b2 = last ? nB : cB + (size_t)(t + 2) * kstep;
            const char* a3 = a2 + kstep; const char* b3 = b2 + kstep;
            PG8_LDB(B0, 0, 0); PG8_LDB(B1, 0, 1); PG8_SCHED; PG8_LDA(At, 0, 0); PG8_STAGE(PG8_SA(1, 1), a1 + hstepA, voffA);
            PG8_WAIT_V(8); PG8_WAIT_L(0); PG8_BAR; PG8_MMA(0, 0, At, B0); PG8_MMA(0, 1, At, B1); PG8_BAR; PG8_SCHED;
            PG8_LDA(At, 0, 1); PG8_STAGE(PG8_SB(0, 0), b2, voffB); PG8_STAGE(PG8_SB(0, 1), b2 + hstepB, voffB); PG8_STAGE(PG8_SA(0, 0), a2, voffA);
            PG8_WAIT_V(8); PG8_WAIT_L(0); PG8_BAR; PG8_MMA(1, 0, At, B0); PG8_MMA(1, 1, At, B1); PG8_BAR; PG8_SCHED;
            PG8_LDB(B0, 1, 0); PG8_LDB(B1, 1, 1); PG8_SCHED; PG8_LDA(At, 1, 0); PG8_STAGE(PG8_SA(0, 1), a2 + hstepA, voffA);
            PG8_WAIT_V(8); PG8_WAIT_L(0); PG8_BAR; PG8_MMA(0, 0, At, B0); PG8_MMA(0, 1, At, B1); PG8_BAR; PG8_SCHED;
            PG8_LDA(At, 1, 1); PG8_STAGE(PG8_SB(1, 0), b3, voffB); PG8_STAGE(PG8_SB(1, 1), b3 + hstepB, voffB); PG8_STAGE(PG8_SA(1, 0), a3, voffA);
            PG8_WAIT_V(8); PG8_WAIT_L(0); PG8_BAR; PG8_MMA(1, 0, At, B0); PG8_MMA(1, 1, At, B1); PG8_BAR; PG8_SCHED;
        }
        if (wr == 0) PG8_BAR;
        E(acc, cur, wr, wc, fr, fq);
        if (!has_next) break;
#pragma unroll
        for (int a = 0; a < 2; ++a)
#pragma unroll
            for (int b = 0; b < 2; ++b)
#pragma unroll
                for (int m = 0; m < 4; ++m)
#pragma unroll
                    for (int n = 0; n < 2; ++n) acc[a][b][m][n] = (f32x4){0.f, 0.f, 0.f, 0.f};
        cur = nxt; cA = nA; cB = nB; ++ui;
        if (wr == 1) PG8_BAR;
    }
    PG8_WAIT_V(0);
    PG8_BAR;
#undef PG8_SA
#undef PG8_SB
#undef PG8_STAGE
#undef PG8_LDA
#undef PG8_LDB
#undef PG8_MMA
#undef PG8_WAIT_V
#undef PG8_WAIT_L
#undef PG8_BAR
#undef PG8_SCHED
}

struct SchedSimple {
    Tiles t; const char* A; const char* B; size_t astride, bstride;
    __device__ bool next(int i, Unit& u) const { if (!t.tile(i, u.pm, u.pn)) return false; u.aux = 0; u.a = A + (size_t)u.pm * astride; u.b = B + (size_t)u.pn * bstride; return true; }
};
struct SchedTwoPass {
    Tiles t; const char* A0; const char* A1; const char* B0; const char* B1; size_t astride, bstride;
    __device__ bool next(int i, Unit& u) const { if (!t.tile(i >> 1, u.pm, u.pn)) return false; u.aux = i & 1;
        u.a = (u.aux ? A1 : A0) + (size_t)u.pm * astride; u.b = (u.aux ? B1 : B0) + (size_t)u.pn * bstride; return true; }
};
struct SchedWeff {
    Tiles t; const char* A; const char* B; size_t astride, bstride;
    __device__ bool next(int i, Unit& u) const { if (!t.tile(i, u.pm, u.pn)) return false; u.aux = 0; u.a = A + (size_t)u.pm * astride; u.b = B + (size_t)u.pn * bstride + (size_t)u.pm * 512; return true; }
};

#define EPI_BEGIN { const int row0 = u.pm * 256 + wr * 64 + fr, col0 = u.pn * 256 + wc * 32 + 8 * fq; \
    _Pragma("unroll") for (int ai = 0; ai < 2; ++ai) _Pragma("unroll") for (int m = 0; m < 4; ++m) _Pragma("unroll") for (int bj = 0; bj < 2; ++bj) { \
        int row = row0 + ai * 128 + m * 16; const int col = col0 + bj * 128; asm volatile("" : "+v"(row)); f32x4 v0 = acc[ai][bj][m][0], v1 = acc[ai][bj][m][1];
#define EPI_END } }
typedef const f32x4 (&AccRef)[2][2][4][2];

struct Epi1 {
    bf16_t *QS, *KS, *QF, *KF, *VTS, *VTF, *G;
    __device__ __forceinline__ void operator()(AccRef acc, const Unit& u, int wr, int wc, int fr, int fq) const {
        const int pn = u.pn;
        if (pn >= 24) {
            EPI_BEGIN { f32x4 a, b;
#pragma unroll
                for (int e = 0; e < 4; ++e) { a[e] = sigmoidf_(v0[e]); b[e] = sigmoidf_(v1[e]); }
                *(u32x4*)(G + (size_t)row * 4096 + (col - 6144)) = pack8(a, b); } EPI_END
        } else {
            const int t = pn >> 2;
            if (t == 2 || t == 5) {
                bf16_t* VT = (t == 2) ? VTS : VTF;
                EPI_BEGIN { const int c = col - t * 1024; const int hh = c >> 7, d = c & 127; const int b = row >> 12, s = row & 4095;
                    bf16_t* p = VT + ((size_t)((b * 8 + hh) * 128 + d)) * SEQ + s; const u32x4 w = pack8(v0, v1);
                    p[0] = (bf16_t)(w.x & 0xffff); p[SEQ] = (bf16_t)(w.x >> 16); p[2 * SEQ] = (bf16_t)(w.y & 0xffff); p[3 * SEQ] = (bf16_t)(w.y >> 16);
                    p[4 * SEQ] = (bf16_t)(w.z & 0xffff); p[5 * SEQ] = (bf16_t)(w.z >> 16); p[6 * SEQ] = (bf16_t)(w.w & 0xffff); p[7 * SEQ] = (bf16_t)(w.w >> 16); } EPI_END
            } else {
                bf16_t* dst = (t == 0) ? QS : (t == 1) ? KS : (t == 3) ? QF : KF; const float sc = (t == 0 || t == 3) ? QSCALE : 1.f;
                EPI_BEGIN { *(u32x4*)(dst + (size_t)row * 1024 + (col - t * 1024)) = pack8(v0 * sc, v1 * sc); } EPI_END
            }
        }
    }
};
struct EpiBf16Plain { bf16_t* O; int ldc;
    __device__ __forceinline__ void operator()(AccRef acc, const Unit& u, int wr, int wc, int fr, int fq) const {
        EPI_BEGIN { *(u32x4*)(O + (size_t)row * ldc + col) = pack8(v0, v1); } EPI_END } };
struct EpiWeff { bf16_t* O; const float* gain;
    __device__ __forceinline__ void operator()(AccRef acc, const Unit& u, int wr, int wc, int fr, int fq) const {
        EPI_BEGIN { const f32x4 g0 = *(const f32x4*)(gain + col), g1 = *(const f32x4*)(gain + col + 4); *(u32x4*)(O + (size_t)row * DM + col) = pack8(v0 * g0, v1 * g1); } EPI_END } };
struct Epi2 { const bf16_t* G; float* T1; bf16_t* MG;
    __device__ __forceinline__ void operator()(AccRef acc, const Unit& u, int wr, int wc, int fr, int fq) const {
        if (u.aux == 0) {
            EPI_BEGIN { const u32x4 gv = *(const u32x4*)(G + (size_t)row * 4096 + col);
                f32x4 a = {bflo(gv.x), bfhi(gv.x), bflo(gv.y), bfhi(gv.y)}, b = {bflo(gv.z), bfhi(gv.z), bflo(gv.w), bfhi(gv.w)};
                float* tp = T1 + (size_t)row * DM + col; *(f32x4*)tp = v0 * a; *(f32x4*)(tp + 4) = v1 * b; } EPI_END
        } else {
            EPI_BEGIN { const u32x4 gv = *(const u32x4*)(G + (size_t)row * 4096 + 2048 + col);
                f32x4 a = {bflo(gv.x), bfhi(gv.x), bflo(gv.y), bfhi(gv.y)}, b = {bflo(gv.z), bfhi(gv.z), bflo(gv.w), bfhi(gv.w)};
                const float* tp = T1 + (size_t)row * DM + col; const f32x4 t0 = *(const f32x4*)tp, t1 = *(const f32x4*)(tp + 4);
                *(u32x4*)(MG + (size_t)row * DM + col) = pack8(t0 + v0 * a, t1 + v1 * b); } EPI_END
        }
    } };
struct Epi3 { const float* HIN; float* HOUT; bf16_t* XB; float* RS;
    __device__ __forceinline__ void operator()(AccRef acc, const Unit& u, int wr, int wc, int fr, int fq) const {
        const int row0 = u.pm * 256 + wr * 64 + fr, col0 = u.pn * 256 + wc * 32 + 8 * fq;
#pragma unroll
        for (int ai = 0; ai < 2; ++ai)
#pragma unroll
            for (int m = 0; m < 4; ++m) {
                int row = row0 + ai * 128 + m * 16; asm volatile("" : "+v"(row));
                float ssq = 0.f;
#pragma unroll
                for (int bj = 0; bj < 2; ++bj) {
                    const int col = col0 + bj * 128;
                    const float* ip = HIN + (size_t)row * DM + col; float* op = HOUT + (size_t)row * DM + col;
                    const f32x4 h0 = *(const f32x4*)ip + acc[ai][bj][m][0], h1 = *(const f32x4*)(ip + 4) + acc[ai][bj][m][1];
                    *(f32x4*)op = h0; *(f32x4*)(op + 4) = h1;
                    *(u32x4*)(XB + (size_t)row * DM + col) = pack8(h0, h1);
                    ssq += (h0[0] * h0[0] + h0[1] * h0[1]) + (h0[2] * h0[2] + h0[3] * h0[3]) + (h1[0] * h1[0] + h1[1] * h1[1]) + (h1[2] * h1[2] + h1[3] * h1[3]);
                }
                ssq += __shfl_xor(ssq, 16); ssq += __shfl_xor(ssq, 32);
                if (fq == 0) (void)__hip_atomic_fetch_add(RS + row, ssq, __ATOMIC_RELAXED, __HIP_MEMORY_SCOPE_AGENT);
            }
    } };
struct EpiF32 { float* O; const float* RS;
    __device__ __forceinline__ void operator()(AccRef acc, const Unit& u, int wr, int wc, int fr, int fq) const {
        EPI_BEGIN { const float rstd = __builtin_amdgcn_rsqf(RS[row] * (1.f / DM) + EPS); float* op = O + (size_t)row * DM + col; *(f32x4*)op = v0 * rstd; *(f32x4*)(op + 4) = v1 * rstd; } EPI_END } };
struct Epi10 { float* H; const bf16_t* PE;
    __device__ __forceinline__ void operator()(AccRef acc, const Unit& u, int wr, int wc, int fr, int fq) const {
        EPI_BEGIN { const u32x4 pv = *(const u32x4*)(PE + (size_t)row * DM + col);
            f32x4 a = {bflo(pv.x), bfhi(pv.x), bflo(pv.y), bfhi(pv.y)}, b = {bflo(pv.z), bfhi(pv.z), bflo(pv.w), bfhi(pv.w)};
            f32x4 s0, s1;
#pragma unroll
            for (int e = 0; e < 4; ++e) { s0[e] = sigmoidf_(v0[e]); s1[e] = sigmoidf_(v1[e]); }
            float* hp = H + (size_t)row * DM + col; const f32x4 h0 = *(const f32x4*)hp, h1 = *(const f32x4*)(hp + 4);
            *(f32x4*)hp = h0 + s0 * a; *(f32x4*)(hp + 4) = h1 + s1 * b; } EPI_END } };
}

namespace att {
constexpr int KP = 272, VP = 144, KTB = 64 * KP, VTB = 128 * VP, BUFB = KTB + VTB;
constexpr int F2_OFF = 2 * BUFB, FLAG_OFF = F2_OFF + 16384, WT_OFF = FLAG_OFF + 64;
constexpr float NEG_INF = -__builtin_inff();
constexpr float DEAD = -160.f;

#define MFMA32(a, b, c) __builtin_amdgcn_mfma_f32_32x32x16_bf16((a), (b), (c), 0, 0, 0)

template <bool FOX>
__device__ __forceinline__ void item(LAS unsigned char* lds, const bf16_t* Qp, const bf16_t* __restrict__ Kp, const bf16_t* __restrict__ VTp, bf16_t* Op,
                                     const float* __restrict__ LF, const int b, const int h, const int qb) {
    int tid = threadIdx.x; asm volatile("" : "+v"(tid));
    const int wave = __builtin_amdgcn_readfirstlane(tid >> 6), lane = tid & 63, g = lane >> 5, ql = lane & 31;
    const int q0 = qb * 256, myrow0 = q0 + wave * 32, myq = myrow0 + ql;
    const size_t tokbase = (size_t)b * SEQ;
    const bf16_t* Kg = Kp + tokbase * 1024 + h * 128;
    const bf16_t* Vg = VTp + (size_t)((b * 8 + h) * 128) * SEQ;
    const int kr = tid >> 4, kc = tid & 15, vr = tid >> 3, vc = tid & 7;
    u32x4 kreg0, kreg1, vreg0, vreg1;
#define ATT_LOAD(kt) { const bf16_t* kp_ = Kg + (size_t)((kt) * 64 + kr) * 1024 + kc * 8; kreg0 = *(const u32x4*)kp_; kreg1 = *(const u32x4*)(kp_ + 32 * 1024); \
        const bf16_t* vp_ = Vg + (size_t)vr * SEQ + (kt) * 64 + vc * 8; vreg0 = *(const u32x4*)vp_; vreg1 = *(const u32x4*)(vp_ + (size_t)64 * SEQ); }
#define ATT_STORE(buf) { LAS unsigned char* kb_ = lds + (buf) * BUFB; *(LAS u32x4*)(kb_ + kr * KP + kc * 16) = kreg0; *(LAS u32x4*)(kb_ + (kr + 32) * KP + kc * 16) = kreg1; \
        LAS unsigned char* vb_ = kb_ + KTB; *(LAS u32x4*)(vb_ + vr * VP + vc * 16) = vreg0; *(LAS u32x4*)(vb_ + (vr + 64) * VP + vc * 16) = vreg1; }
    const int kt_hi = qb * 4 + 3;
    __syncthreads();
    ATT_LOAD(kt_hi);
    bf16x8 qf[8];
    { const bf16_t* qp = Qp + (tokbase + myq) * 1024 + h * 128 + 8 * g;
#pragma unroll
      for (int kk = 0; kk < 8; ++kk) qf[kk] = *(const bf16x8*)(qp + 16 * kk); }
    LAS float* F2 = (LAS float*)(lds + F2_OFF);
    LAS int* flags = (LAS int*)(lds + FLAG_OFF);
    LAS float* WT = (LAS float*)(lds + WT_OFF);
    if (tid < 16) flags[tid] = 0;
    if (FOX) {
        const float* lf = LF + (size_t)(b * 8 + h) * SEQ + 8 * tid;
        const f32x4 a = *(const f32x4*)lf, c = *(const f32x4*)(lf + 4);
        float p[8]; p[0] = a[0]; p[1] = p[0] + a[1]; p[2] = p[1] + a[2]; p[3] = p[2] + a[3]; p[4] = p[3] + c[0]; p[5] = p[4] + c[1]; p[6] = p[5] + c[2]; p[7] = p[6] + c[3];
        float sc = p[7];
#pragma unroll
        for (int off = 1; off < 64; off <<= 1) { const float t = __shfl_up(sc, off); if (lane >= off) sc += t; }
        if (lane == 63) WT[wave] = sc;
        __syncthreads();
        float base = sc - p[7];
        for (int w = 0; w < wave; ++w) base += WT[w];
        *(LAS f32x4*)(F2 + 8 * tid) = (f32x4){base + p[0], base + p[1], base + p[2], base + p[3]};
        *(LAS f32x4*)(F2 + 8 * tid + 4) = (f32x4){base + p[4], base + p[5], base + p[6], base + p[7]};
    }
    ATT_STORE(0);
    __syncthreads();
    const int kl = 16 * (ql >> 4) + 8 * ((ql >> 2) & 1) + 4 * ((ql >> 3) & 1) + (ql & 3);
    const int koff = kl * KP + 16 * g;
    const int voff = KTB + ql * VP + 16 * g;
    f32x16 o[4];
#pragma unroll
    for (int d = 0; d < 4; ++d)
#pragma unroll
        for (int i = 0; i < 16; ++i) o[d][i] = 0.f;
    float carry = 0.f;
    float m_run = NEG_INF, l_run = 0.f;
    int it = 0;
    for (int kt = kt_hi; kt >= 0; --kt, ++it) {
        const int cur = it & 1;
        if (kt > 0) ATT_LOAD(kt - 1);
        if (!FOX && it > 0) {
            int alldead = 1;
#pragma unroll
            for (int w = 0; w < 8; ++w) alldead &= flags[((it - 1) & 1) * 8 + w];
            if (alldead) break;
        }
        LAS const unsigned char* buf = lds + cur * BUFB;
        const int k0 = kt * 64;
#pragma unroll
        for (int kb2 = 1; kb2 >= 0; --kb2) {
            const int kbase = k0 + 32 * kb2;
            const bool skip = FOX ? (kbase > myrow0 + 31) : (kbase >= myrow0 + 31);
            if (skip) continue;
            const bool need_mask = FOX ? (kbase + 31 > myrow0) : (kbase + 31 >= myrow0);
            f32x16 s;
#pragma unroll
            for (int i = 0; i < 16; ++i) s[i] = 0.f;
            { LAS const unsigned char* kb = buf + kb2 * 32 * KP + koff;
#pragma unroll
              for (int kk = 0; kk < 8; ++kk) { const bf16x8 kf = *(LAS const bf16x8*)(kb + 32 * kk); s = MFMA32(kf, qf[kk], s); } }
            const int sp0 = kbase + 8 * g;
            float pr[16];
            if (!FOX) {
                float l1m[16], lb[16];
#pragma unroll
                for (int i = 0; i < 16; ++i) {
                    const float y = s[i];
                    const float sp2 = fmaxf(y, 0.f) + __builtin_amdgcn_logf(1.f + __builtin_amdgcn_exp2f(-fabsf(y)));
                    const bool valid = !need_mask || (sp0 + 16 * (i >> 3) + (i & 7) < myq);
                    l1m[i] = valid ? -sp2 : 0.f; lb[i] = valid ? (y - sp2) : NEG_INF;
                }
                float aft[16], R0 = 0.f, R1 = 0.f;
#pragma unroll
                for (int e = 7; e >= 0; --e) { aft[e] = R0; R0 += l1m[e]; aft[8 + e] = R1; R1 += l1m[8 + e]; }
                const float P0 = __shfl_xor(R0, 32), P1 = __shfl_xor(R1, 32);
                const float off1 = carry + (g ? 0.f : P1);
                const float off0 = carry + (g ? (R1 + P1) : (P1 + R1 + P0));
#pragma unroll
                for (int i = 0; i < 16; ++i) pr[i] = __builtin_amdgcn_exp2f(lb[i] + aft[i] + (i < 8 ? off0 : off1));
                carry += (R0 + R1) + (P0 + P1);
            } else {
                float y2[16];
#pragma unroll
                for (int c = 0; c < 2; ++c) {
                    const f32x4 fa = *(LAS const f32x4*)(F2 + sp0 + 16 * c), fb = *(LAS const f32x4*)(F2 + sp0 + 16 * c + 4);
#pragma unroll
                    for (int e = 0; e < 4; ++e) { y2[8 * c + e] = s[8 * c + e] - fa[e]; y2[8 * c + 4 + e] = s[8 * c + 4 + e] - fb[e]; }
                }
                if (need_mask) {
#pragma unroll
                    for (int i = 0; i < 16; ++i) y2[i] = (sp0 + 16 * (i >> 3) + (i & 7) <= myq) ? y2[i] : NEG_INF;
                }
                float bm = y2[0];
#pragma unroll
                for (int i = 1; i < 16; ++i) bm = fmaxf(bm, y2[i]);
                bm = fmaxf(bm, __shfl_xor(bm, 32));
                const float mn = fmaxf(m_run, bm);
                const float ms = (mn == NEG_INF) ? 0.f : mn;
                const float alpha = __builtin_amdgcn_exp2f(m_run - ms);
                float rs = 0.f;
#pragma unroll
                for (int i = 0; i < 16; ++i) { pr[i] = __builtin_amdgcn_exp2f(y2[i] - ms); rs += pr[i]; }
                l_run = l_run * alpha + rs; m_run = mn;
                if (__builtin_amdgcn_ballot_w64(alpha != 1.f) != 0ull) {
#pragma unroll
                    for (int d = 0; d < 4; ++d)
#pragma unroll
                        for (int i = 0; i < 16; ++i) o[d][i] *= alpha;
                }
            }
            bf16x8 pc0, pc1;
            { const u32x4 w0 = pack8((f32x4){pr[0], pr[1], pr[2], pr[3]}, (f32x4){pr[4], pr[5], pr[6], pr[7]});
              const u32x4 w1 = pack8((f32x4){pr[8], pr[9], pr[10], pr[11]}, (f32x4){pr[12], pr[13], pr[14], pr[15]});
              pc0 = __builtin_bit_cast(bf16x8, w0); pc1 = __builtin_bit_cast(bf16x8, w1); }
            { LAS const unsigned char* vb = buf + voff + kb2 * 64;
#pragma unroll
              for (int d = 0; d < 4; ++d) {
                  const bf16x8 vf0 = *(LAS const bf16x8*)(vb + d * 32 * VP), vf1 = *(LAS const bf16x8*)(vb + d * 32 * VP + 32);
                  o[d] = MFMA32(vf0, pc0, o[d]); o[d] = MFMA32(vf1, pc1, o[d]);
              } }
        }
        if (!FOX) { const int dead = (__builtin_amdgcn_ballot_w64(carry < DEAD) == ~0ull) ? 1 : 0; if (lane == 0) flags[cur * 8 + wave] = dead; }
        if (kt > 0) ATT_STORE(cur ^ 1);
        __syncthreads();
    }
    if (FOX) {
        const float lt = l_run + __shfl_xor(l_run, 32);
        const float inv = 1.f / lt;
#pragma unroll
        for (int d = 0; d < 4; ++d)
#pragma unroll
            for (int i = 0; i < 16; ++i) o[d][i] *= inv;
    }
    { bf16_t* op = Op + (tokbase + myq) * 1024 + h * 128 + 4 * g;
#pragma unroll
      for (int d = 0; d < 4; ++d)
#pragma unroll
          for (int a = 0; a < 4; ++a) {
              u32x2 w; w.x = cvt_pk_bf16(o[d][4 * a], o[d][4 * a + 1]); w.y = cvt_pk_bf16(o[d][4 * a + 2], o[d][4 * a + 3]);
              *(u32x2*)(op + 32 * d + 8 * a) = w;
          } }
#undef ATT_LOAD
#undef ATT_STORE
}
}

namespace peer {
__device__ __forceinline__ unsigned ord_key(float f) { const unsigned u = __builtin_bit_cast(unsigned, f); return (u & 0x80000000u) ? ~u : (u | 0x80000000u); }
__device__ __forceinline__ float ord_val(unsigned k) { const unsigned u = (k & 0x80000000u) ? (k & 0x7fffffffu) : ~k; return __builtin_bit_cast(float, u); }
template <int C> __device__ __forceinline__ unsigned dppu(unsigned v) { return (unsigned)__builtin_amdgcn_update_dpp(0, (int)v, C, 0xF, 0xF, false); }
template <int C> __device__ __forceinline__ float dppf(float v) { return __builtin_bit_cast(float, __builtin_amdgcn_update_dpp(0, __builtin_bit_cast(int, v), C, 0xF, 0xF, false)); }
__device__ __forceinline__ unsigned umax_(unsigned a, unsigned b) { return a > b ? a : b; }
#ifndef PEER_NO_DPP
__device__ __forceinline__ unsigned rowmax_u(unsigned v) { v = umax_(v, dppu<0x128>(v)); v = umax_(v, dppu<0x124>(v)); v = umax_(v, dppu<0x122>(v)); v = umax_(v, dppu<0x121>(v)); return v; }
__device__ __forceinline__ float rowsum_f(float v) { v += dppf<0x128>(v); v += dppf<0x124>(v); v += dppf<0x122>(v); v += dppf<0x121>(v); return v; }
#else
__device__ __forceinline__ unsigned rowmax_u(unsigned v) { v = umax_(v, (unsigned)__shfl_xor((int)v, 8)); v = umax_(v, (unsigned)__shfl_xor((int)v, 4)); v = umax_(v, (unsigned)__shfl_xor((int)v, 2)); v = umax_(v, (unsigned)__shfl_xor((int)v, 1)); return v; }
__device__ __forceinline__ float rowsum_f(float v) { v += __shfl_xor(v, 8); v += __shfl_xor(v, 4); v += __shfl_xor(v, 2); v += __shfl_xor(v, 1); return v; }
#endif

__device__ __forceinline__ float dot8(u32x4 a, u32x4 b, float d) {
#pragma unroll
#ifdef PEER_FDOT2
    for (int t = 0; t < 4; ++t) d = __builtin_amdgcn_fdot2_f32_bf16(__builtin_bit_cast(bf16v2, a[t]), __builtin_bit_cast(bf16v2, b[t]), d, false);
#else
    for (int t = 0; t < 4; ++t) { d += bflo(a[t]) * bflo(b[t]); d += bfhi(a[t]) * bfhi(b[t]); }
#endif
    return d;
}

__device__ __forceinline__ void token(LAS unsigned char* wlds, const float* __restrict__ SC, const bf16_t* __restrict__ XIN, bf16_t* XN, float* H, const unsigned char* __restrict__ EU, const unsigned char* __restrict__ EV, const float* __restrict__ SU, const float* __restrict__ SV, const float* __restrict__ RS, const int m, const int lane_in, const bool dry = false) {
    int lane = lane_in; asm volatile("" : "+v"(lane));
    LAS int* widx = (LAS int*)wlds;
    LAS float* wgate = (LAS float*)(wlds + 512);
    LAS float* wcoef = (LAS float*)(wlds + 1024);
    const int r = lane >> 4, l16 = lane & 15, pp = r & 1;
#pragma unroll 1
    for (int rd = 0; rd < 4; ++rd) {
        const float* sp = SC + (size_t)m * 2048 + (4 * rd + r) * 128 + l16 * 8;
        const f32x4 a = *(const f32x4*)sp, c = *(const f32x4*)(sp + 4);
        unsigned key[8];
#pragma unroll
        for (int e = 0; e < 4; ++e) { key[e] = (ord_key(a[e]) & ~0xFFu) | (unsigned)(255 - (l16 * 8 + e)); key[4 + e] = (ord_key(c[e]) & ~0xFFu) | (unsigned)(255 - (l16 * 8 + 4 + e)); }
#define PEER_CE(i, j) { const unsigned hi_ = umax_(key[i], key[j]), lo_ = key[i] < key[j] ? key[i] : key[j]; key[i] = hi_; key[j] = lo_; }
        PEER_CE(0, 1) PEER_CE(2, 3) PEER_CE(4, 5) PEER_CE(6, 7) PEER_CE(0, 2) PEER_CE(1, 3) PEER_CE(4, 6) PEER_CE(5, 7) PEER_CE(1, 2) PEER_CE(5, 6) PEER_CE(0, 4) PEER_CE(3, 7)
        PEER_CE(1, 5) PEER_CE(2, 6) PEER_CE(1, 4) PEER_CE(3, 6) PEER_CE(2, 4) PEER_CE(3, 5) PEER_CE(3, 4)
#undef PEER_CE
        unsigned mine = 0u;
#pragma unroll 1
        for (int itn = 0; itn < 16; ++itn) {
            const unsigned rm = rowmax_u(key[0]);
            const bool won = (key[0] == rm);
            mine = (l16 == itn) ? rm : mine;
#pragma unroll
            for (int e = 0; e < 7; ++e) key[e] = won ? key[e + 1] : key[e];
            key[7] = won ? 0u : key[7];
        }
        const float myv = ord_val(mine & ~0xFFu);
        const float s1 = __shfl(myv, (lane & 32) | l16);
        unsigned ck[8];
#pragma unroll
        for (int e = 0; e < 8; ++e) { const float s2 = __shfl(myv, (lane & 32) + 16 + 8 * pp + e); ck[e] = (ord_key(s1 + s2) & ~0xFFu) | (unsigned)(255 - (l16 * 16 + 8 * pp + e)); }
        unsigned sel = 0u;
#pragma unroll 1
        for (int itn = 0; itn < 16; ++itn) {
            unsigned rm = rowmax_u(ck[0]);
            rm = umax_(rm, (unsigned)__shfl_xor((int)rm, 16));
            const bool won = (ck[0] == rm);
            sel = (l16 == itn) ? rm : sel;
#pragma unroll
            for (int e = 0; e < 7; ++e) ck[e] = won ? ck[e + 1] : ck[e];
            ck[7] = won ? 0u : ck[7];
        }
        const float tv = ord_val(sel & ~0xFFu); const int cidx = 255 - (int)(sel & 0xFFu); const int ci = cidx >> 4, cj = cidx & 15;
        const unsigned k1 = (unsigned)__shfl((int)mine, (lane & 32) | ci), k2 = (unsigned)__shfl((int)mine, (lane & 32) + 16 + cj);
        const int expert = (255 - (int)(k1 & 0xFFu)) * 128 + (255 - (int)(k2 & 0xFFu));
        const float mx = ord_val(rowmax_u(sel) & ~0xFFu);
        const float ex = __expf(tv - mx);
        const float gate = ex / rowsum_f(ex);
        if (pp == 0) { const int slot = (2 * rd + (r >> 1)) * 16 + l16; widx[slot] = expert; wgate[slot] = gate; }
    }
    __builtin_amdgcn_wave_barrier(); asm volatile("s_waitcnt lgkmcnt(0)" ::: "memory");
    asm volatile("" : "+v"(lane));
    f32x2 xf[16];
    { const u32x4* xp = (const u32x4*)(XIN + (size_t)m * DM + 32 * lane);
#pragma unroll
      for (int c = 0; c < 4; ++c) { const u32x4 w = xp[c];
#pragma unroll
          for (int t = 0; t < 4; ++t) xf[4 * c + t] = (f32x2){bflo(w[t]), bfhi(w[t])}; } }
#if PEER_FP4
    u32x4 bA[8], bB[8];
#define PEER_LOAD(buf, grp, TABLE) { _Pragma("unroll") for (int e = 0; e < 8; ++e) { const int id = __builtin_amdgcn_readfirstlane(widx[(grp) * 8 + e]); \
        buf[e] = *(const u32x4*)((TABLE) + (size_t)id * ROWB + 16 * lane); } }
#define PEER_DOT(buf, base) { _Pragma("unroll") for (int e = 0; e < 8; ++e) { f32x2 d2 = {0.f, 0.f}; \
        _Pragma("unroll") for (int q = 0; q < 4; ++q) { const unsigned w = buf[e][q]; \
            d2 = d2 + __builtin_amdgcn_cvt_scalef32_pk_f32_fp4(w, 1.0f, 0) * xf[4 * q]; d2 = d2 + __builtin_amdgcn_cvt_scalef32_pk_f32_fp4(w, 1.0f, 1) * xf[4 * q + 1]; \
            d2 = d2 + __builtin_amdgcn_cvt_scalef32_pk_f32_fp4(w, 1.0f, 2) * xf[4 * q + 2]; d2 = d2 + __builtin_amdgcn_cvt_scalef32_pk_f32_fp4(w, 1.0f, 3) * xf[4 * q + 3]; } \
        part[(base) + e] = d2.x + d2.y; } }
#else
    v6u bA[8], bB[8];
#define PEER_LOAD(buf, grp, TABLE) { _Pragma("unroll") for (int e = 0; e < 8; ++e) { const int id = __builtin_amdgcn_readfirstlane(widx[(grp) * 8 + e]); \
        const unsigned char* rp = (TABLE) + (size_t)id * ROWB + 24 * lane; const u32x4 w4 = *(const u32x4*)rp; const u32x2 w2 = *(const u32x2*)(rp + 16); \
        buf[e] = (v6u){w4[0], w4[1], w4[2], w4[3], w2[0], w2[1]}; } }
#define PEER_DOT(buf, base) { _Pragma("unroll") for (int e = 0; e < 8; ++e) { const v32f r = __builtin_amdgcn_cvt_scalef32_pk32_f32_fp6(buf[e], 1.0f); f32x2 d2 = {0.f, 0.f}; \
        _Pragma("unroll") for (int i = 0; i < 16; ++i) d2 = d2 + (f32x2){r[2 * i], r[2 * i + 1]} * xf[i]; part[(base) + e] = d2.x + d2.y; } }
#endif
    const float rstd_in = __builtin_amdgcn_rsqf(RS[m] * (1.f / DM) + EPS);
    PEER_LOAD(bA, 0, EU);
#pragma unroll 1
    for (int hd = 0; hd < 8; ++hd) {
        float part[16];
        const int myid = widx[hd * 16 + (lane & 15)];
        const float su = SU[myid], sv = SV[myid];
        PEER_LOAD(bB, 2 * hd + 1, EU); PEER_DOT(bA, 0); __builtin_amdgcn_sched_barrier(0);
        { const int gn = min(2 * hd + 2, 15); PEER_LOAD(bA, gn, EU); } PEER_DOT(bB, 8); __builtin_amdgcn_sched_barrier(0);
        float r8[8], r4[4], r2[2], r1;
        { const bool b0 = lane & 1;
#pragma unroll
          for (int t = 0; t < 8; ++t) { const float keep = b0 ? part[2 * t + 1] : part[2 * t], send = b0 ? part[2 * t] : part[2 * t + 1]; r8[t] = keep + __shfl_xor(send, 1); } }
        { const bool b1 = lane & 2;
#pragma unroll
          for (int t = 0; t < 4; ++t) { const float keep = b1 ? r8[2 * t + 1] : r8[2 * t], send = b1 ? r8[2 * t] : r8[2 * t + 1]; r4[t] = keep + __shfl_xor(send, 2); } }
        { const bool b2 = lane & 4;
#pragma unroll
          for (int t = 0; t < 2; ++t) { const float keep = b2 ? r4[2 * t + 1] : r4[2 * t], send = b2 ? r4[2 * t] : r4[2 * t + 1]; r2[t] = keep + __shfl_xor(send, 4); } }
        { const bool b3 = lane & 8; const float keep = b3 ? r2[1] : r2[0], send = b3 ? r2[0] : r2[1]; r1 = keep + __shfl_xor(send, 8); }
        r1 += __shfl_xor(r1, 16); r1 += __shfl_xor(r1, 32);
        r1 *= su * rstd_in;
        const float hid = 0.5f * r1 * (1.f + erff(r1 * 0.70710678118654752f));
        if (lane < 16) wcoef[hd * 16 + lane] = wgate[hd * 16 + lane] * hid * sv;
    }
    __builtin_amdgcn_wave_barrier(); asm volatile("s_waitcnt lgkmcnt(0)" ::: "memory");
    asm volatile("" : "+v"(lane));
    f32x2 acc2[16];
#pragma unroll
    for (int i = 0; i < 16; ++i) acc2[i] = (f32x2){0.f, 0.f};
#if PEER_FP4
#define PEER_FMA(buf, grp) { _Pragma("unroll") for (int e = 0; e < 8; ++e) { const float cf = wcoef[(grp) * 8 + e]; const f32x2 cf2 = {cf, cf}; \
        _Pragma("unroll") for (int q = 0; q < 4; ++q) { const unsigned w = buf[e][q]; \
            acc2[4 * q] = acc2[4 * q] + cf2 * __builtin_amdgcn_cvt_scalef32_pk_f32_fp4(w, 1.0f, 0); acc2[4 * q + 1] = acc2[4 * q + 1] + cf2 * __builtin_amdgcn_cvt_scalef32_pk_f32_fp4(w, 1.0f, 1); \
            acc2[4 * q + 2] = acc2[4 * q + 2] + cf2 * __builtin_amdgcn_cvt_scalef32_pk_f32_fp4(w, 1.0f, 2); acc2[4 * q + 3] = acc2[4 * q + 3] + cf2 * __builtin_amdgcn_cvt_scalef32_pk_f32_fp4(w, 1.0f, 3); } } }
#else
#define PEER_FMA(buf, grp) { _Pragma("unroll") for (int e = 0; e < 8; ++e) { const float cf = wcoef[(grp) * 8 + e]; const f32x2 cf2 = {cf, cf}; const v32f r = __builtin_amdgcn_cvt_scalef32_pk32_f32_fp6(buf[e], 1.0f); \
        _Pragma("unroll") for (int i = 0; i < 16; ++i) acc2[i] = acc2[i] + cf2 * (f32x2){r[2 * i], r[2 * i + 1]}; } }
#endif
    PEER_LOAD(bA, 0, EV);
#pragma unroll 1
    for (int gp = 0; gp < 8; ++gp) {
        PEER_LOAD(bB, 2 * gp + 1, EV); PEER_FMA(bA, 2 * gp); __builtin_amdgcn_sched_barrier(0);
        { const int gn = min(2 * gp + 2, 15); PEER_LOAD(bA, gn, EV); } PEER_FMA(bB, 2 * gp + 1); __builtin_amdgcn_sched_barrier(0);
    }
    float ss = 0.f;
    float* hp = H + (size_t)m * DM + 32 * lane;
#pragma unroll
    for (int q = 0; q < 8; ++q) {
        f32x4 h0 = *(const f32x4*)(hp + 4 * q);
        h0[0] += acc2[2 * q].x; h0[1] += acc2[2 * q].y; h0[2] += acc2[2 * q + 1].x; h0[3] += acc2[2 * q + 1].y;
        acc2[2 * q] = (f32x2){h0[0], h0[1]}; acc2[2 * q + 1] = (f32x2){h0[2], h0[3]};
        ss += (h0[0] * h0[0] + h0[1] * h0[1]) + (h0[2] * h0[2] + h0[3] * h0[3]);
        if (!dry || ss == 12345.678f) *(f32x4*)(hp + 4 * q) = h0;
    }
    const float rstd = __builtin_amdgcn_rsqf(wave_sum(ss) * (1.f / DM) + EPS);
    { u32x4* xo = (u32x4*)(XN + (size_t)m * DM + 32 * lane);
#pragma unroll
      for (int c = 0; c < 4; ++c) { u32x4 w;
#pragma unroll
          for (int t = 0; t < 4; ++t) w[t] = cvt_pk_bf16(acc2[4 * c + t].x * rstd, acc2[4 * c + t].y * rstd);
          if (!dry || ss == 12345.678f) xo[c] = w; } }
#undef PEER_LOAD
#undef PEER_DOT
#undef PEER_FMA
}
}


#define XB_TMO      128
#define XB_XCNT(j)  (256  + 64 * (j))
#define XB_XSUB(j)  (1280 + 64 * (j))
#define XB_XGEN(j)  (2304 + 64 * (j))
#define XB_TOP      3328
#define XB_TOPGEN   3392
#define XCD_BAR_WORDS 3456
#define XB_SPIN_CAP (1u << 22)
__device__ __forceinline__ unsigned xb_ld(unsigned* p)              { return __hip_atomic_load(p, __ATOMIC_RELAXED, __HIP_MEMORY_SCOPE_AGENT); }
__device__ __forceinline__ unsigned xb_add(unsigned* p, unsigned v) { return __hip_atomic_fetch_add(p, v, __ATOMIC_RELAXED, __HIP_MEMORY_SCOPE_AGENT); }
__device__ __forceinline__ unsigned xb_xcc_id() { return (unsigned)__builtin_amdgcn_s_getreg((3 << 11) | 20) & 0xFu; }
#define XB_SPIN(cond, bar) do { unsigned _sp = 0; while (cond) { __builtin_amdgcn_s_sleep(1); \
    if ((++_sp & 255u) == 0u) { if (xb_ld(&(bar)[XB_TMO])) break; if (_sp > XB_SPIN_CAP) { atomicAdd(&(bar)[XB_TMO], 1u); break; } } } } while (0)
struct XcdBarrier { unsigned* bar; unsigned x; volatile LAS unsigned* st; };
__device__ __forceinline__ XcdBarrier xcd_barrier_post(unsigned* bar, volatile LAS unsigned* st) {
    XcdBarrier b; b.bar = bar; b.x = xb_xcc_id(); b.st = st;
    if (threadIdx.x == 0) (void)xb_add(&bar[XB_XCNT(b.x)], 1u);
    return b;
}
__device__ __forceinline__ void xcd_barrier_complete(unsigned* bar, unsigned x, unsigned& nloc, unsigned& nx) {
    const unsigned G = gridDim.x * gridDim.y * gridDim.z;
    unsigned sum, cnt, mine, sp = 0u;
    for (;;) {
        sum = 0u; cnt = 0u; mine = 0u;
#pragma unroll
        for (unsigned j = 0; j < 16; ++j) { const unsigned c = xb_ld(&bar[XB_XCNT(j)]); sum += c; cnt += (c > 0u) ? 1u : 0u; mine = (j == x) ? c : mine; }
        if (sum == G) break;
        __builtin_amdgcn_s_sleep(1);
        if ((++sp & 255u) == 0u) { if (xb_ld(&bar[XB_TMO])) break; if (sp > XB_SPIN_CAP) { atomicAdd(&bar[XB_TMO], 1u); break; } }
    }
    nloc = mine > 0u ? mine : 1u; nx = cnt > 0u ? cnt : 1u;
}
__device__ __forceinline__ void xcd_barrier(const XcdBarrier& b) {
    asm volatile("s_waitcnt vmcnt(0)" ::: "memory");
    __syncthreads();
    if (threadIdx.x == 0) {
        unsigned* bar = b.bar;
        __builtin_amdgcn_s_waitcnt(0);
        unsigned nloc = b.st[0], nx = b.st[1];
        if (nloc == 0u) { xcd_barrier_complete(bar, b.x, nloc, nx); b.st[0] = nloc; b.st[1] = nx; }
        const unsigned old = xb_add(&bar[XB_XSUB(b.x)], 1u);
        const unsigned gen = old / nloc;
        if (old + 1u == (gen + 1u) * nloc) {
            __builtin_amdgcn_fence(__ATOMIC_RELEASE, "agent");
            asm volatile("s_waitcnt vmcnt(0)" ::: "memory");
            const unsigned og = xb_add(&bar[XB_TOP], 1u);
            const unsigned tg = og / nx;
            if (og + 1u == (tg + 1u) * nx) xb_add(&bar[XB_TOPGEN], 1u);
            else XB_SPIN(xb_ld(&bar[XB_TOPGEN]) == tg, bar);
            __builtin_amdgcn_fence(__ATOMIC_ACQUIRE, "agent");
            xb_add(&bar[XB_XGEN(b.x)], 1u);
            asm volatile("s_waitcnt vmcnt(0)" ::: "memory");
        } else {
            XB_SPIN(xb_ld(&bar[XB_XGEN(b.x)]) == gen, bar);
            __builtin_amdgcn_fence(__ATOMIC_ACQUIRE, "agent");
            asm volatile("s_waitcnt vmcnt(0)" ::: "memory");
        }
    }
    __syncthreads();
}

constexpr size_t MiB = 1u << 20;
constexpr size_t WS_H = 0;
constexpr size_t WS_XN = 128 * MiB;
constexpr size_t WS_QS = 192 * MiB, WS_KS = 224 * MiB, WS_QF = 256 * MiB, WS_KF = 288 * MiB;
constexpr size_t WS_VTS = 320 * MiB, WS_VTF = 352 * MiB;
constexpr size_t WS_G = 384 * MiB;
constexpr size_t WS_T1 = 512 * MiB;
constexpr size_t WS_PE = 640 * MiB;
constexpr size_t WS_EU = 704 * MiB, WS_EV = 768 * MiB;
constexpr size_t WS_W1T = 832 * MiB;
constexpr size_t WS_WBS = 872 * MiB, WS_WBF = 876 * MiB;
constexpr size_t WS_WOT = 880 * MiB;
constexpr size_t WS_WQB = 888 * MiB;
constexpr size_t WS_WEFF = 896 * MiB;
constexpr size_t WS_WPGT = 904 * MiB;
constexpr size_t WS_WPLT = 912 * MiB;
constexpr size_t WS_SKP = 913 * MiB;
constexpr size_t WS_PB = 914 * MiB;
constexpr size_t WS_LF = 922 * MiB;
constexpr size_t WS_SU = 923 * MiB, WS_SV = WS_SU + 65536;
constexpr size_t WS_OS = 924 * MiB, WS_OF = 956 * MiB;
constexpr size_t WS_CTL = 988 * MiB, CTL_BYTES = 65536;
constexpr size_t WS_RS = 989 * MiB;
constexpr size_t WS_END = 990 * MiB;

struct Args { const float* in[17]; float* out; unsigned char* ws; int ph_lo, ph_hi; };

__device__ __forceinline__ void transpose_item(const float* __restrict__ W, int ldw, int c0, int k0, const float* __restrict__ scale, bf16_t* WT, int ldt, int drow0, LAS float* scr, int lane) {
#pragma unroll 8
    for (int i = 0; i < 32; ++i) { const int kk = 2 * i + (lane >> 5); float v = W[(size_t)(k0 + kk) * ldw + c0 + (lane & 31)]; if (scale) v *= scale[k0 + kk]; scr[kk * 33 + (lane & 31)] = v; }
    asm volatile("s_waitcnt lgkmcnt(0)" ::: "memory");
    const int c = lane & 7;
#pragma unroll
    for (int j = 0; j < 4; ++j) { const int n = (lane >> 3) + 8 * j; const LAS float* s = scr + (8 * c) * 33 + n;
        u32x4 o; o.x = cvt_pk_bf16(s[0 * 33], s[1 * 33]); o.y = cvt_pk_bf16(s[2 * 33], s[3 * 33]); o.z = cvt_pk_bf16(s[4 * 33], s[5 * 33]); o.w = cvt_pk_bf16(s[6 * 33], s[7 * 33]);
        *(u32x4*)(WT + (size_t)(drow0 + n) * ldt + k0 + 8 * c) = o; }
    asm volatile("s_waitcnt lgkmcnt(0)" ::: "memory");
}
__device__ __forceinline__ float fp6_val(int c) { return c < 8 ? 0.125f * c : c < 16 ? 1.f + 0.125f * (c - 8) : c < 24 ? 2.f + 0.25f * (c - 16) : 4.f + 0.5f * (c - 24); }
__device__ __forceinline__ int fp6_code(float v) { return v < 1.f ? (int)(v * 8.f + 0.5f) : v < 2.f ? 8 + (int)((v - 1.f) * 8.f + 0.5f) : v < 4.f ? 16 + (int)((v - 2.f) * 4.f + 0.5f) : 24 + (int)((v - 4.f) * 2.f + 0.5f); }
__device__ __forceinline__ void fp6_probe(LAS int* wl, LAS int* posl) {
    float z = 0.f; asm volatile("" : "+v"(z));
    v16f px, py;
#pragma unroll
    for (int i = 0; i < 16; ++i) { px[i] = fp6_val(i) + z; py[i] = fp6_val(16 + i) + z; }
    const v6u pk = __builtin_amdgcn_cvt_scalef32_2xpk16_fp6_f32(px, py, 1.0f);
    const v32f pr = __builtin_amdgcn_cvt_scalef32_pk32_f32_fp6(pk, 1.0f);
#pragma unroll
    for (int k = 0; k < 32; ++k) wl[fp6_code(pr[k]) & 31] = k;
    asm volatile("s_waitcnt lgkmcnt(0)" ::: "memory");
    (void)posl;
}
__device__ __forceinline__ void quant_row_fp6(const float* __restrict__ src, const float* __restrict__ colscale, unsigned char* dst, float* rscale, int row, int lane, LAS float* stage, LAS const int* pos) {
    const float* rp = src + (size_t)row * DM + 32 * lane;
    f32x4 v[8]; float amax = 0.f;
#pragma unroll
    for (int q = 0; q < 8; ++q) { f32x4 t = *(const f32x4*)(rp + 4 * q); if (colscale) t = t * *(const f32x4*)(colscale + 32 * lane + 4 * q);
        v[q] = t; amax = fmaxf(fmaxf(amax, fmaxf(fabsf(t[0]), fabsf(t[1]))), fmaxf(fabsf(t[2]), fabsf(t[3]))); }
#pragma unroll
    for (int o = 1; o < 64; o <<= 1) amax = fmaxf(amax, __shfl_xor(amax, o));
    const float inv = amax > 0.f ? 7.25f / amax : 0.f;
    LAS float* my = stage + lane * 33;
#pragma unroll
    for (int q = 0; q < 8; ++q) { my[4 * q] = v[q][0] * inv; my[4 * q + 1] = v[q][1] * inv; my[4 * q + 2] = v[q][2] * inv; my[4 * q + 3] = v[q][3] * inv; }
    asm volatile("s_waitcnt lgkmcnt(0)" ::: "memory");
    v16f ex, ey;
#pragma unroll
    for (int j = 0; j < 16; ++j) { ex[j] = my[pos[j]]; ey[j] = my[pos[16 + j]]; }
    asm volatile("s_waitcnt lgkmcnt(0)" ::: "memory");
    const v6u pk = __builtin_amdgcn_cvt_scalef32_2xpk16_fp6_f32(ex, ey, 1.0f);
    u32x2* dp = (u32x2*)(dst + (size_t)row * ROWB + 24 * lane);
    dp[0] = (u32x2){pk[0], pk[1]}; dp[1] = (u32x2){pk[2], pk[3]}; dp[2] = (u32x2){pk[4], pk[5]};
    if (lane == 0) rscale[row] = amax * (1.f / 7.25f);
}
__device__ __forceinline__ void quant_row_fp4(const float* __restrict__ src, const float* __restrict__ colscale, unsigned char* dst, float* rscale, int row, int lane) {
    const float* rp = src + (size_t)row * DM + 32 * lane;
    f32x4 v[8]; float amax = 0.f;
#pragma unroll
    for (int q = 0; q < 8; ++q) { f32x4 t = *(const f32x4*)(rp + 4 * q); if (colscale) t = t * *(const f32x4*)(colscale + 32 * lane + 4 * q);
        v[q] = t; amax = fmaxf(fmaxf(amax, fmaxf(fabsf(t[0]), fabsf(t[1]))), fmaxf(fabsf(t[2]), fabsf(t[3]))); }
#pragma unroll
    for (int o = 1; o < 64; o <<= 1) amax = fmaxf(amax, __shfl_xor(amax, o));
    const float inv = amax > 0.f ? 6.f / amax : 0.f;
    u32x4 w;
#pragma unroll
    for (int q = 0; q < 4; ++q) { const f32x4 a = v[2 * q] * inv, b = v[2 * q + 1] * inv; unsigned p = 0u;
        p = __builtin_amdgcn_cvt_scalef32_pk_fp4_f32(p, a[0], a[1], 1.0f, 0); p = __builtin_amdgcn_cvt_scalef32_pk_fp4_f32(p, a[2], a[3], 1.0f, 1);
        p = __builtin_amdgcn_cvt_scalef32_pk_fp4_f32(p, b[0], b[1], 1.0f, 2); p = __builtin_amdgcn_cvt_scalef32_pk_fp4_f32(p, b[2], b[3], 1.0f, 3); w[q] = p; }
    *(u32x4*)(dst + (size_t)row * ROWB + 16 * lane) = w;
    if (lane == 0) rscale[row] = amax * (1.f / 6.f);
}
__device__ __forceinline__ void convert_flat(const float* __restrict__ src, bf16_t* dst, size_t n8, const float* __restrict__ scale, size_t gt, size_t ngt) {
    for (size_t i = gt; i < n8; i += ngt) {
        f32x4 a = *(const f32x4*)(src + 8 * i), b = *(const f32x4*)(src + 8 * i + 4);
        if (scale) { const int k = (int)((8 * i) & 2047); a = a * *(const f32x4*)(scale + k); b = b * *(const f32x4*)(scale + k + 4); }
        *(u32x4*)(dst + 8 * i) = pack8(a, b);
    }
}

#define PH_BEGIN unsigned char* ws = args.ws; asm volatile("" : "+s"(ws)); int L = Lc; asm volatile("" : "+s"(L)); \
    int tid = threadIdx.x; asm volatile("" : "+v"(tid)); const int lane = tid & 63, wave = __builtin_amdgcn_readfirstlane(tid >> 6); const int G = gridDim.x, bid = blockIdx.x; \
    const int gw = bid * NWAVES + wave, NGW = G * NWAVES; (void)gw; (void)NGW; (void)lane; (void)ws; (void)L;
#define WSP(T, off) ((T*)(ws + (off)))
#define INP(i, stride) (args.in[i] + (size_t)L * (stride))

__device__ __forceinline__ void rms_rows_to_bf16(const float* __restrict__ hsrc, bf16_t* XN, int gw, int NGW, int lane) {
    for (int m = gw; m < M; m += NGW) {
        const float* hr = hsrc + (size_t)m * DM + 4 * lane;
        f32x4 v[8]; float ss = 0.f;
#pragma unroll
        for (int j = 0; j < 8; ++j) { v[j] = *(const f32x4*)(hr + 256 * j); ss += (v[j][0] * v[j][0] + v[j][1] * v[j][1]) + (v[j][2] * v[j][2] + v[j][3] * v[j][3]); }
        const float rstd = __builtin_amdgcn_rsqf(wave_sum(ss) * (1.f / DM) + EPS);
        u32x2* xo = (u32x2*)(XN + (size_t)m * DM) + lane;
#pragma unroll
        for (int j = 0; j < 8; ++j) { v[j] = v[j] * rstd; u32x2 w; w.x = cvt_pk_bf16(v[j][0], v[j][1]); w.y = cvt_pk_bf16(v[j][2], v[j][3]); xo[64 * j] = w; }
    }
}

__global__ void __launch_bounds__(NTHREADS, 2) fwd_kernel(Args args) {
    extern __shared__ __attribute__((aligned(16))) unsigned char lds_raw[];
    LAS unsigned char* lds = (LAS unsigned char*)lds_raw;
    cg::grid_group grid = cg::this_grid();
    const int lo = args.ph_lo, hi = args.ph_hi;
    volatile LAS unsigned* bst = (volatile LAS unsigned*)(lds + LDS_BYTES - 64);
    if (threadIdx.x < 2) bst[threadIdx.x] = 0u;
    __syncthreads();
    const XcdBarrier xbar = xcd_barrier_post((unsigned*)(args.ws + WS_CTL), bst);
#ifndef ONLY_PHASE
#define ONLY_PHASE -1
#endif
#define PH_EN(k) (ONLY_PHASE < 0 || ONLY_PHASE == (k))
#define RUN(p) (lo <= (p) && (p) < hi)
#ifndef REP_SYNC
#define REP_SYNC 1
#endif
#define SEAM(p) do { if ((p) + 1 < hi) { for (int rs_ = 0; rs_ < REP_SYNC; ++rs_) { if (MK_SPLIT == 0 && (p) != 0) xcd_barrier(xbar); else { asm volatile("s_waitcnt vmcnt(0)" ::: "memory"); grid.sync(); } } } } while (0)

#pragma unroll 1
    for (int Lc = 0; Lc < DEPTH; ++Lc) {
        const int P = Lc * 9;

        if (PH_EN(0) && RUN(P + 0)) {
#ifndef REP_P0
#define REP_P0 1
#endif
          for (int rep = 0; rep < REP_P0; ++rep) {
            PH_BEGIN
            const float* g_mix = INP(2, DM); const float* w_in = INP(3, (size_t)DM * INC);
            {
                const float* w_bsb = INP(5, (size_t)1024 * DM); const float* w_bfx = INP(6, (size_t)1024 * DM); const float* w_out = INP(7, (size_t)DM * DM);
                const float* g_ple = INP(13, DM); const float* w_ple = INP(14, (size_t)PLE * DM); const float* w_pg = INP(15, (size_t)DM * DM);
                bf16_t *W1T = WSP(bf16_t, WS_W1T), *WBS = WSP(bf16_t, WS_WBS), *WBF = WSP(bf16_t, WS_WBF), *WOT = WSP(bf16_t, WS_WOT), *WPGT = WSP(bf16_t, WS_WPGT), *WPLT = WSP(bf16_t, WS_WPLT);
                LAS float* scr = (LAS float*)(lds + wave * 16384);
                constexpr int I_IN = 32 * 320, I_B = 16 * 64, I_O = 32 * 64, I_PL = 4 * 64;
                constexpr int NITEMS = I_IN + 2 * I_B + 2 * I_O + I_PL;
                for (int itn = gw; itn < NITEMS; itn += NGW) {
                    int r = itn;
                    if (r < I_IN) { const int kb = r / 320, nb = r % 320, n0 = 32 * nb; transpose_item(w_in, INC, n0 + (n0 >= 6144 ? 8 : 0), 64 * kb, g_mix, W1T, DM, n0, scr, lane); continue; } r -= I_IN;
                    if (r < I_B) { const int kb = r / 64, nb = r % 64; transpose_item(w_bsb, DM, 32 * nb, 64 * kb, nullptr, WBS, 1024, 32 * nb, scr, lane); continue; } r -= I_B;
                    if (r < I_B) { const int kb = r / 64, nb = r % 64; transpose_item(w_bfx, DM, 32 * nb, 64 * kb, nullptr, WBF, 1024, 32 * nb, scr, lane); continue; } r -= I_B;
                    if (r < I_O) { const int kb = r / 64, nb = r % 64; transpose_item(w_out, DM, 32 * nb, 64 * kb, nullptr, WOT, DM, 32 * nb, scr, lane); continue; } r -= I_O;
                    if (r < I_O) { const int kb = r / 64, nb = r % 64; transpose_item(w_pg, DM, 32 * nb, 64 * kb, g_ple, WPGT, DM, 32 * nb, scr, lane); continue; } r -= I_O;
                    { const int kb = r / 64, nb = r % 64; transpose_item(w_ple, DM, 32 * nb, 64 * kb, nullptr, WPLT, PLE, 32 * nb, scr, lane); }
                }
            }
            {
                const float* g_ffn = INP(8, DM); const float* sub_keys = INP(10, (size_t)16 * 128 * 128);
                bf16_t* SKP = WSP(bf16_t, WS_SKP);
                const size_t gt = (size_t)bid * NTHREADS + tid, ngt = (size_t)G * NTHREADS;
                convert_flat(INP(9, (size_t)DM * DM), WSP(bf16_t, WS_WQB), (size_t)DM * DM / 8, nullptr, gt, ngt);
                { const float* eu = INP(11, (size_t)NEXP * DM); const float* ev = INP(12, (size_t)NEXP * DM);
#if PEER_FP4
                  for (int rr = gw; rr < 2 * NEXP; rr += NGW) { if (rr < NEXP) quant_row_fp4(eu, g_ffn, WSP(unsigned char, WS_EU), WSP(float, WS_SU), rr, lane); else quant_row_fp4(ev, nullptr, WSP(unsigned char, WS_EV), WSP(float, WS_SV), rr - NEXP, lane); } }
#else
                  LAS float* stage = (LAS float*)(lds + wave * 16384); LAS int* pos = (LAS int*)(lds + wave * 16384 + 8704); fp6_probe(pos, pos);
                  for (int rr = gw; rr < 2 * NEXP; rr += NGW) { if (rr < NEXP) quant_row_fp6(eu, g_ffn, WSP(unsigned char, WS_EU), WSP(float, WS_SU), rr, lane, stage, pos); else quant_row_fp6(ev, nullptr, WSP(unsigned char, WS_EV), WSP(float, WS_SV), rr - NEXP, lane, stage, pos); } }
#endif
                convert_flat(INP(1, (size_t)M * PLE), WSP(bf16_t, WS_PB), (size_t)M * PLE / 8, nullptr, gt, ngt);
                for (size_t i = gt; i < (size_t)M; i += ngt) WSP(float, WS_RS)[i] = 0.f;
                for (size_t i = gt; i < (size_t)2048 * 256 / 8; i += ngt) {
                    const int n = (int)(i >> 5), c8 = (int)(i & 31) * 8, pp = (n >> 7) & 1;
                    u32x4 o = {0u, 0u, 0u, 0u};
                    if ((c8 >> 7) == pp) { const float* sp = sub_keys + (size_t)n * 128 + (c8 & 127); o = pack8(*(const f32x4*)sp, *(const f32x4*)(sp + 4)); }
                    *(u32x4*)(SKP + (size_t)n * 256 + c8) = o;
                }
            }
            __syncthreads();
            {
                const float* h_in = (L == 0) ? args.in[0] : WSP(const float, WS_H);
                const float* b_f = INP(4, NH);
                bf16_t* XN = WSP(bf16_t, WS_XN); float* LF = WSP(float, WS_LF);
                LAS float* WF = (LAS float*)lds;
                for (int i = tid; i < 8 * DM; i += NTHREADS) { const int k = i >> 3, j = i & 7; WF[j * DM + k] = w_in[(size_t)k * INC + 6144 + j] * g_mix[k]; }
                __syncthreads();
                for (int m = gw; m < M; m += NGW) {
                    const float* hr = h_in + (size_t)m * DM + 4 * lane;
                    f32x4 v[8]; float ss = 0.f;
#pragma unroll
                    for (int j = 0; j < 8; ++j) { v[j] = *(const f32x4*)(hr + 256 * j); ss += (v[j][0] * v[j][0] + v[j][1] * v[j][1]) + (v[j][2] * v[j][2] + v[j][3] * v[j][3]); }
                    const float rstd = __builtin_amdgcn_rsqf(wave_sum(ss) * (1.f / DM) + EPS);
                    u32x2* xo = (u32x2*)(XN + (size_t)m * DM) + lane;
#pragma unroll
                    for (int j = 0; j < 8; ++j) { v[j] = v[j] * rstd; u32x2 w; w.x = cvt_pk_bf16(v[j][0], v[j][1]); w.y = cvt_pk_bf16(v[j][2], v[j][3]); xo[64 * j] = w; }
                    float myf = 0.f;
#pragma unroll
                    for (int hh = 0; hh < 8; ++hh) {
                        float d = 0.f;
#pragma unroll
                        for (int j = 0; j < 8; ++j) { const f32x4 w = *(const LAS f32x4*)(WF + hh * DM + 256 * j + 4 * lane); d += (v[j][0] * w[0] + v[j][1] * w[1]) + (v[j][2] * w[2] + v[j][3] * w[3]); }
                        d = wave_sum(d);
                        myf = (lane == hh) ? d : myf;
                    }
                    if (lane < 8) {
                        const float xx = myf + b_f[lane];
                        const float ls = fminf(xx, 0.f) - log1pf(__expf(-fabsf(xx)));
                        LF[(size_t)((m >> 12) * 8 + lane) * SEQ + (m & 4095)] = ls * LOG2E;
                    }
                }
            }
            __syncthreads();
          }
            SEAM(P + 0);
        }

        if (PH_EN(1) && RUN(P + 1)) {
#ifndef REP_P1
#define REP_P1 1
#endif
          for (int rep = 0; rep < REP_P1; ++rep) {
            { PH_BEGIN
              pg8::SchedSimple S; S.t.init(M / 256, 10240 / 256, G, bid); S.A = (const char*)WSP(bf16_t, WS_XN); S.B = (const char*)WSP(bf16_t, WS_W1T); S.astride = (size_t)256 * DM * 2; S.bstride = (size_t)256 * DM * 2;
              pg8::Epi1 E{WSP(bf16_t, WS_QS), WSP(bf16_t, WS_KS), WSP(bf16_t, WS_QF), WSP(bf16_t, WS_KF), WSP(bf16_t, WS_VTS), WSP(bf16_t, WS_VTF), WSP(bf16_t, WS_G)};
              pg8::gemm_phase(lds, DM, DM, DM, S, E); }
            { PH_BEGIN
              pg8::SchedWeff S; S.t.init(8, 8, G, bid); S.A = (const char*)WSP(bf16_t, WS_SKP); S.B = (const char*)WSP(bf16_t, WS_WQB); S.astride = (size_t)256 * 256 * 2; S.bstride = (size_t)256 * DM * 2;
              pg8::EpiWeff E{WSP(bf16_t, WS_WEFF), INP(8, DM)};
              pg8::gemm_phase(lds, 256, DM, 256, S, E); }
            { PH_BEGIN
              pg8::SchedSimple S; S.t.init(M / 256, 8, G, bid); S.A = (const char*)WSP(bf16_t, WS_PB); S.B = (const char*)WSP(bf16_t, WS_WPLT); S.astride = (size_t)256 * PLE * 2; S.bstride = (size_t)256 * PLE * 2;
              pg8::EpiBf16Plain E{WSP(bf16_t, WS_PE), DM};
              pg8::gemm_phase(lds, PLE, PLE, PLE, S, E); }
          }
            SEAM(P + 1);
        }

        if (PH_EN(2) && RUN(P + 2)) {
#ifndef REP_ATT
#define REP_ATT 1
#endif
          for (int rep = 0; rep < REP_ATT; ++rep) {
            { PH_BEGIN
              bf16_t *QF = WSP(bf16_t, WS_QF), *KF = WSP(bf16_t, WS_KF), *VTF = WSP(bf16_t, WS_VTF), *OF = WSP(bf16_t, WS_OF); const float* LF = WSP(const float, WS_LF);
              for (int w = bid; w < 256; w += G) {
                  const int bh = w >> 3, j = w & 7;
                  att::item<true>(lds, QF, KF, VTF, OF, LF, bh >> 3, bh & 7, 15 - j);
                  att::item<true>(lds, QF, KF, VTF, OF, LF, bh >> 3, bh & 7, j);
              } }
            { PH_BEGIN
              bf16_t *QS = WSP(bf16_t, WS_QS), *KS = WSP(bf16_t, WS_KS), *VTS = WSP(bf16_t, WS_VTS), *OS = WSP(bf16_t, WS_OS);
              for (int w = bid; w < 512; w += G) {
                  const int bh = w >> 4, qb = w & 15;
                  att::item<false>(lds, QS, KS, VTS, OS, nullptr, bh >> 3, bh & 7, qb);
              } }
          }
            SEAM(P + 2);
        }

        if (PH_EN(3) && RUN(P + 3)) {
#ifndef REP_P3
#define REP_P3 1
#endif
          for (int rep = 0; rep < REP_P3; ++rep) {
            PH_BEGIN
            pg8::SchedTwoPass S; S.t.init(M / 256, 8, G, bid); S.A0 = (const char*)WSP(bf16_t, WS_OS); S.A1 = (const char*)WSP(bf16_t, WS_OF); S.B0 = (const char*)WSP(bf16_t, WS_WBS); S.B1 = (const char*)WSP(bf16_t, WS_WBF);
            S.astride = (size_t)256 * 1024 * 2; S.bstride = (size_t)256 * 1024 * 2;
            pg8::Epi2 E{WSP(bf16_t, WS_G), WSP(float, WS_T1), WSP(bf16_t, WS_XN)};
            pg8::gemm_phase(lds, 1024, 1024, 1024, S, E);
          }
            SEAM(P + 3);
        }

        if (PH_EN(4) && RUN(P + 4)) {
            PH_BEGIN
            pg8::SchedSimple S; S.t.init(M / 256, 8, G, bid); S.A = (const char*)WSP(bf16_t, WS_XN); S.B = (const char*)WSP(bf16_t, WS_WOT); S.astride = (size_t)256 * DM * 2; S.bstride = (size_t)256 * DM * 2;
            pg8::Epi3 E{(L == 0) ? args.in[0] : WSP(const float, WS_H), WSP(float, WS_H), WSP(bf16_t, WS_QS)  , WSP(float, WS_RS)};
            pg8::gemm_phase(lds, DM, DM, DM, S, E);
            SEAM(P + 4);
        }


        if (PH_EN(6) && RUN(P + 6)) {
#ifndef REP_P6
#define REP_P6 1
#endif
          for (int rep = 0; rep < REP_P6; ++rep) {
            PH_BEGIN
            pg8::SchedSimple S; S.t.init(M / 256, 8, G, bid); S.A = (const char*)WSP(bf16_t, WS_QS); S.B = (const char*)WSP(bf16_t, WS_WEFF); S.astride = (size_t)256 * DM * 2; S.bstride = (size_t)256 * DM * 2;
            pg8::EpiF32 E{WSP(float, WS_T1), WSP(const float, WS_RS)};
            pg8::gemm_phase(lds, DM, DM, DM, S, E);
          }
            SEAM(P + 6);
        }

        if (PH_EN(7) && RUN(P + 7)) {
            PH_BEGIN
            LAS unsigned char* wl = lds + wave * 2048;
            const float* T1 = WSP(const float, WS_T1); bf16_t* XN = WSP(bf16_t, WS_XN); const bf16_t* XIN = WSP(const bf16_t, WS_QS); float* HB = WSP(float, WS_H); const unsigned char *EU = WSP(const unsigned char, WS_EU), *EV = WSP(const unsigned char, WS_EV); const float *SU = WSP(const float, WS_SU), *SV = WSP(const float, WS_SV), *RS = WSP(const float, WS_RS);
#ifdef REP_PEER
            for (int m = gw; m < M; m += NGW) peer::token(wl, T1, XIN, XN, HB, EU, EV, SU, SV, RS, m, lane, true);
#endif
            for (int m = gw; m < M; m += NGW) peer::token(wl, T1, XIN, XN, HB, EU, EV, SU, SV, RS, m, lane);
            SEAM(P + 7);
        }

        if (PH_EN(8) && RUN(P + 8)) {
            PH_BEGIN
            pg8::SchedSimple S; S.t.init(M / 256, 8, G, bid); S.A = (const char*)WSP(bf16_t, WS_XN); S.B = (const char*)WSP(bf16_t, WS_WPGT); S.astride = (size_t)256 * DM * 2; S.bstride = (size_t)256 * DM * 2;
            pg8::Epi10 E{WSP(float, WS_H), WSP(const bf16_t, WS_PE)};
            pg8::gemm_phase(lds, DM, DM, DM, S, E);
            SEAM(P + 8);
        }
    }
    if (PH_EN(9) && RUN(DEPTH * 9)) {
        const int Lc = 0;
        PH_BEGIN
        const float* gfin = args.in[16]; const float* HB = WSP(const float, WS_H);
        for (int m = gw; m < M; m += NGW) {
            const float* hr = HB + (size_t)m * DM + 4 * lane;
            f32x4 v[8]; float ss = 0.f;
#pragma unroll
            for (int j = 0; j < 8; ++j) { v[j] = *(const f32x4*)(hr + 256 * j); ss += (v[j][0] * v[j][0] + v[j][1] * v[j][1]) + (v[j][2] * v[j][2] + v[j][3] * v[j][3]); }
            const float rstd = __builtin_amdgcn_rsqf(wave_sum(ss) * (1.f / DM) + EPS);
            float* op = args.out + (size_t)m * DM + 4 * lane;
#pragma unroll
            for (int j = 0; j < 8; ++j) { const f32x4 gg = *(const f32x4*)(gfin + 256 * j + 4 * lane); *(f32x4*)(op + 256 * j) = v[j] * rstd * gg; }
        }
    }
#undef RUN
#undef SEAM
}

extern "C" void kernel_launch(void* const* d_in, const int* in_sizes, int n_in, void* d_out, int out_size, void* d_ws, size_t ws_size, hipStream_t stream) {
    static int grid = 0;
    if (grid == 0) {
        if (n_in != 17 || out_size != M * DM || ws_size < WS_END) { fprintf(stderr, "kernel_launch: unexpected problem (n_in %d, out %d, ws %zu)\n", n_in, out_size, ws_size); grid = -1; return; }
        int dev = 0, cus = 0, per_cu = 0;
        hipGetDevice(&dev); hipDeviceGetAttribute(&cus, hipDeviceAttributeMultiprocessorCount, dev);
        if (hipFuncSetAttribute((const void*)fwd_kernel, hipFuncAttributeMaxDynamicSharedMemorySize, LDS_BYTES) != hipSuccess) { fprintf(stderr, "kernel_launch: hipFuncSetAttribute failed\n"); grid = -1; return; }
        if (hipOccupancyMaxActiveBlocksPerMultiprocessor(&per_cu, (const void*)fwd_kernel, NTHREADS, LDS_BYTES) != hipSuccess || per_cu < 1) { fprintf(stderr, "kernel_launch: occupancy query says %d blocks per CU\n", per_cu); per_cu = 1; }
        (void)hipGetLastError();
        grid = cus * per_cu;
        fprintf(stderr, "kernel_launch: grid %d (cus %d x %d)\n", grid, cus, per_cu);
    }
    if (grid < 0) return;
    Args a{};
    for (int i = 0; i < 17; ++i) a.in[i] = (const float*)d_in[i];
    a.out = (float*)d_out; a.ws = (unsigned char*)d_ws;
    constexpr int NPH = DEPTH * 9 + 1;
    if (hipMemsetAsync((char*)d_ws + WS_CTL, 0, CTL_BYTES, stream) != hipSuccess) { fprintf(stderr, "kernel_launch: memset of the barrier words failed\n"); return; }
#if MK_SPLIT
    for (int p = 0; p < NPH; ++p) { a.ph_lo = p; a.ph_hi = p + 1; hipLaunchKernelGGL(fwd_kernel, dim3(grid), dim3(NTHREADS), LDS_BYTES, stream, a); }
#else
    a.ph_lo = 0; a.ph_hi = NPH;
    void* kargs[] = {&a};
    hipError_t e = hipLaunchCooperativeKernel((const void*)fwd_kernel, dim3(grid), dim3(NTHREADS), kargs, LDS_BYTES, stream);
    if (e != hipSuccess) fprintf(stderr, "kernel_launch: cooperative launch failed: %s (grid %d)\n", hipGetErrorString(e), grid);
#endif
}
```

```cpp
#include <hip/hip_runtime.h>
#include <hip/hip_cooperative_groups.h>
#include <cstdio>
#include <cstdint>
namespace cg = cooperative_groups;

#ifndef MK_SPLIT
#define MK_SPLIT 0
#endif

#define LAS __attribute__((address_space(3)))
typedef unsigned short bf16_t;
typedef short bf16x8 __attribute__((ext_vector_type(8)));
typedef float f32x4 __attribute__((ext_vector_type(4)));
typedef float f32x16 __attribute__((ext_vector_type(16)));
typedef unsigned u32x4 __attribute__((ext_vector_type(4)));
typedef unsigned u32x2 __attribute__((ext_vector_type(2)));
typedef __bf16 bf16v2 __attribute__((ext_vector_type(2)));
typedef float f32x2 __attribute__((ext_vector_type(2)));
typedef float v16f __attribute__((ext_vector_type(16)));
typedef float v32f __attribute__((ext_vector_type(32)));
typedef unsigned v6u __attribute__((ext_vector_type(6)));
#ifndef PEER_FP4
#define PEER_FP4 1
#endif
constexpr int ROWB = PEER_FP4 ? 1024 : 1536;

constexpr int M = 16384, DM = 2048, SEQ = 4096, NB = 4, NH = 8, HD = 128, DEPTH = 2;
constexpr int INC = 10248;
constexpr int PLE = 256;
constexpr int NEXP = 16384;
constexpr float LOG2E = 1.4426950408889634f;
constexpr float QSCALE = 0.08838834764831845f * 1.4426950408889634f;
constexpr float EPS = 1e-6f;
constexpr int NWAVES = 8, NTHREADS = 512;
constexpr int LDS_BYTES = 147456;

__device__ __forceinline__ unsigned cvt_pk_bf16(float lo, float hi) { unsigned r; asm volatile("v_cvt_pk_bf16_f32 %0, %1, %2" : "=v"(r) : "v"(lo), "v"(hi)); return r; }
__device__ __forceinline__ u32x4 pack8(f32x4 a, f32x4 b) { u32x4 w; w.x = cvt_pk_bf16(a[0], a[1]); w.y = cvt_pk_bf16(a[2], a[3]); w.z = cvt_pk_bf16(b[0], b[1]); w.w = cvt_pk_bf16(b[2], b[3]); return w; }
__device__ __forceinline__ float bflo(unsigned w) { return __builtin_bit_cast(float, w << 16); }
__device__ __forceinline__ float bfhi(unsigned w) { return __builtin_bit_cast(float, w & 0xffff0000u); }
__device__ __forceinline__ float sigmoidf_(float x) { return __builtin_amdgcn_rcpf(1.f + __builtin_amdgcn_exp2f(-x * LOG2E)); }
__device__ __forceinline__ float wave_sum(float v) {
#pragma unroll
    for (int o = 1; o < 64; o <<= 1) v += __shfl_xor(v, o);
    return v;
}

namespace pg8 {
constexpr int BM = 256, BK = 64, HALF = 128, HTB = HALF * BK * 2, STAGE_BYTES = 8 * HTB, NXCD = 8, WGM = 8;
__host__ __device__ __forceinline__ int lds_byte(int r, int c) { const int st = (r >> 4) * 2 + (c >> 5), rr = r & 15, cc = c & 31, ob = rr * 64 + cc * 2; return st * 1024 + (ob ^ (((ob >> 9) & 1) << 5)); }
__host__ __device__ __forceinline__ void stage_rc(int b, int& R, int& C) { const int st = b / 1024, sb = b % 1024, swz = sb ^ (((sb >> 9) & 1) << 5); R = (st >> 1) * 16 + swz / 64; C = (st & 1) * 32 + (swz % 64) / 2; }
__host__ __device__ __forceinline__ int perm32(int rho) { const int n = rho >> 4, i = rho & 15; return 8 * (i >> 2) + 4 * n + (i & 3); }

struct Unit { int pm, pn, aux; const char* a; const char* b; };
struct Tiles {
    int nM, nN, nwg, G, c;
    __device__ void init(int nM_, int nN_, int G_, int c_) { nM = nM_; nN = nN_; nwg = nM * nN; G = G_; c = c_; }
    __device__ bool tile(int i, int& pm, int& pn) const {
        const long L = (long)i * G + c; if (L >= nwg) return false;
        int wgid = (int)L; { const int q = nwg / NXCD, r = nwg % NXCD, xcd = wgid % NXCD, off = wgid / NXCD; wgid = (xcd < r ? xcd * (q + 1) : r * (q + 1) + (xcd - r) * q) + off; }
        const int nig = WGM * nN, gid = wgid / nig, fm = gid * WGM, gsz = (nM - fm) < WGM ? (nM - fm) : WGM;
        pm = fm + ((wgid % nig) % gsz); pn = (wgid % nig) / gsz; return true;
    }
};

template <class Epi, class Sched, bool HAS_MID = false>
__device__ __forceinline__ void gemm_phase(LAS unsigned char* lds, const int lda, const int ldb, const int K, const Sched& S, const Epi& E) {
    int tid = threadIdx.x; asm volatile("" : "+v"(tid));
    const int wid = __builtin_amdgcn_readfirstlane(tid >> 6), lane = tid & 63, wr = wid >> 2, wc = wid & 3, fr = lane & 15, fq = lane >> 4;
    int Kv = K; asm volatile("" : "+s"(Kv));
    const int nt = Kv / BK;
    unsigned voffA[2], voffB[2];
#pragma unroll
    for (int i = 0; i < 2; ++i) { int R, C; stage_rc(tid * 16 + i * 8192, R, C); const int Rb = (R & ~31) + perm32(R & 31);
        voffA[i] = (unsigned)(R * lda + C) * 2u; voffB[i] = (unsigned)(Rb * ldb + C) * 2u; }
    const size_t kstep = (size_t)(BK * 2);
    const size_t hstepA = (size_t)HALF * lda * 2, hstepB = (size_t)HALF * ldb * 2;
    const unsigned ldsw = (unsigned)wid * 1024u;
    const int aoff = lds_byte(wr * 64 + fr, fq * 8), boff = lds_byte(wc * 32 + fr, fq * 8);
#define PG8_SA(b, h) (((b) * 2 + (h)) * HTB)
#define PG8_SB(b, h) ((4 + (b) * 2 + (h)) * HTB)
#define PG8_STAGE(bufoff, gbase, voff) do { _Pragma("unroll") for (int _i = 0; _i < 2; ++_i) \
        __builtin_amdgcn_global_load_lds((const unsigned*)((const char*)(gbase) + (voff)[_i]), (LAS unsigned*)(lds + (bufoff) + ldsw + _i * 8192), 16, 0, 0); } while (0)
#define PG8_LDA(dst, b, h) do { _Pragma("unroll") for (int m = 0; m < 4; ++m) _Pragma("unroll") for (int k = 0; k < 2; ++k) dst[m][k] = *(const LAS bf16x8*)(lds + PG8_SA(b, h) + aoff + m * 2048 + k * 1024); } while (0)
#define PG8_LDB(dst, b, h) do { _Pragma("unroll") for (int n = 0; n < 2; ++n) _Pragma("unroll") for (int k = 0; k < 2; ++k) dst[n][k] = *(const LAS bf16x8*)(lds + PG8_SB(b, h) + boff + n * 2048 + k * 1024); } while (0)
#define PG8_MMA(ai, bj, At, Bt) do { __builtin_amdgcn_s_setprio(1); _Pragma("unroll") for (int m = 0; m < 4; ++m) _Pragma("unroll") for (int n = 0; n < 2; ++n) _Pragma("unroll") for (int k = 0; k < 2; ++k) \
        acc[ai][bj][m][n] = __builtin_amdgcn_mfma_f32_16x16x32_bf16(Bt[n][k], At[m][k], acc[ai][bj][m][n], 0, 0, 0); __builtin_amdgcn_s_setprio(0); } while (0)
#define PG8_WAIT_V(n) asm volatile("s_waitcnt vmcnt(" #n ")" ::: "memory")
#define PG8_WAIT_L(n) asm volatile("s_waitcnt lgkmcnt(" #n ")" ::: "memory")
#define PG8_BAR __builtin_amdgcn_s_barrier()
#define PG8_SCHED __builtin_amdgcn_sched_barrier(0)
    Unit cur, nxt; int ui = 0;
    if (!S.next(0, cur)) return;
    f32x4 acc[2][2][4][2];
#pragma unroll
    for (int a = 0; a < 2; ++a)
#pragma unroll
        for (int b = 0; b < 2; ++b)
#pragma unroll
            for (int m = 0; m < 4; ++m)
#pragma unroll
                for (int n = 0; n < 2; ++n) acc[a][b][m][n] = (f32x4){0.f, 0.f, 0.f, 0.f};
    bf16x8 At[4][2], B0[2][2], B1[2][2];
    const char* cA = cur.a; const char* cB = cur.b;
    PG8_STAGE(PG8_SB(0, 0), cB, voffB); PG8_STAGE(PG8_SB(0, 1), cB + hstepB, voffB); PG8_STAGE(PG8_SA(0, 0), cA, voffA); PG8_STAGE(PG8_SA(0, 1), cA + hstepA, voffA);
    if (wr == 1) PG8_BAR;
    PG8_WAIT_V(2); PG8_BAR;
    PG8_STAGE(PG8_SB(1, 0), cB + kstep, voffB); PG8_STAGE(PG8_SA(1, 0), cA + kstep, voffA); PG8_STAGE(PG8_SB(1, 1), cB + hstepB + kstep, voffB);
    PG8_WAIT_V(6); PG8_BAR;
    for (;;) {
        const bool has_next = S.next(ui + 1, nxt);
        const char* nA = has_next ? nxt.a : cA; const char* nB = has_next ? nxt.b : cB;
        for (int t = 0; t < nt; t += 2) {
            const bool last = (t == nt - 2);
            if constexpr (HAS_MID) { if (t == (nt >> 1)) E.mid(acc, cur, wr, wc, fr, fq); }
            const char* a1 = cA + (size_t)(t + 1) * kstep;
            const char* a2 = last ? nA : cA + (size_t)(t + 2) * kstep; const char* b2 = last ? nB : cB + (size_t)(t + 2) * kstep;
            const char* a3 = a2 + kstep; const char* b3 = b2 + kstep;
            PG8_LDB(B0, 0, 0); PG8_LDB(B1, 0, 1); PG8_SCHED; PG8_LDA(At, 0, 0); PG8_STAGE(PG8_SA(1, 1), a1 + hstepA, voffA);
            PG8_WAIT_V(8); PG8_WAIT_L(0); PG8_BAR; PG8_MMA(0, 0, At, B0); PG8_MMA(0, 1, At, B1); PG8_BAR; PG8_SCHED;
            PG8_LDA(At, 0, 1); PG8_STAGE(PG8_SB(0, 0), b2, voffB); PG8_STAGE(PG8_SB(0, 1), b2 + hstepB, voffB); PG8_STAGE(PG8_SA(0, 0), a2, voffA);
            PG8_WAIT_V(8); PG8_WAIT_L(0); PG8_BAR; PG8_MMA(1, 0, At, B0); PG8_MMA(1, 1, At, B1); PG8_BAR; PG8_SCHED;
            PG8_LDB(B0, 1, 0); PG8_LDB(B1, 1, 1); PG8_SCHED; PG8_LDA(At, 1, 0); PG8_STAGE(PG8_SA(0, 1), a2 + hstepA, voffA);
            PG8_WAIT_V(8); PG8_WAIT_L(0); PG8_BAR; PG8_MMA(0, 0, At, B0); PG8_MMA(0, 1, At, B1); PG8_BAR; PG8_SCHED;
            PG8_LDA(At, 1, 1); PG8_STAGE(PG8_SB(1, 0), b3, voffB); PG8_STAGE(PG8_SB(1, 1), b3 + hstepB, voffB); PG8_STAGE(PG8_SA(1, 0), a3, voffA);
            PG8_WAIT_V(8); PG8_WAIT_L(0); PG8_BAR; PG8_MMA(1, 0, At, B0); PG8_MMA(1, 1, At, B1); PG8_BAR; PG8_SCHED;
        }
        if (wr == 0) PG8_BAR;
        E(acc, cur, wr, wc, fr, fq);
        if (!has_next) break;
#pragma unroll
        for (int a = 0; a < 2; ++a)
#pragma unroll
            for (int b = 0; b < 2; ++b)
#pragma unroll
                for (int m = 0; m < 4; ++m)
#pragma unroll
                    for (int n = 0; n < 2; ++n) acc[a][b][m][n] = (f32x4){0.f, 0.f, 0.f, 0.f};
        cur = nxt; cA = nA; cB = nB; ++ui;
        if (wr == 1) PG8_BAR;
    }
    PG8_WAIT_V(0);
    PG8_BAR;
#undef PG8_SA
#undef PG8_SB
#undef PG8_STAGE
#undef PG8_LDA
#undef PG8_LDB
#undef PG8_MMA
#undef PG8_WAIT_V
#undef PG8_WAIT_L
#undef PG8_BAR
#undef PG8_SCHED
}

struct SchedSimple {
    Tiles t; const char* A; const char* B; size_t astride, bstride;
    __device__ bool next(int i, Unit& u) const { if (!t.tile(i, u.pm, u.pn)) return false; u.aux = 0; u.a = A + (size_t)u.pm * astride; u.b = B + (size_t)u.pn * bstride; return true; }
};
struct SchedTwoPass {
    Tiles t; const char* A0; const char* A1; const char* B0; const char* B1; size_t astride, bstride;
    __device__ bool next(int i, Unit& u) const { if (!t.tile(i >> 1, u.pm, u.pn)) return false; u.aux = i & 1;
        u.a = (u.aux ? A1 : A0) + (size_t)u.pm * astride; u.b = (u.aux ? B1 : B0) + (size_t)u.pn * bstride; return true; }
};
struct SchedWeff {
    Tiles t; const char* A; const char* B; size_t astride, bstride;
    __device__ bool next(int i, Unit& u) const { if (!t.tile(i, u.pm, u.pn)) return false; u.aux = 0; u.a = A + (size_t)u.pm * astride; u.b = B + (size_t)u.pn * bstride + (size_t)u.pm * 512; return true; }
};

#define EPI_BEGIN { const int row0 = u.pm * 256 + wr * 64 + fr, col0 = u.pn * 256 + wc * 32 + 8 * fq; \
    _Pragma("unroll") for (int ai = 0; ai < 2; ++ai) _Pragma("unroll") for (int m = 0; m < 4; ++m) _Pragma("unroll") for (int bj = 0; bj < 2; ++bj) { \
        int row = row0 + ai * 128 + m * 16; const int col = col0 + bj * 128; asm volatile("" : "+v"(row)); f32x4 v0 = acc[ai][bj][m][0], v1 = acc[ai][bj][m][1];
#define EPI_END } }
typedef const f32x4 (&AccRef)[2][2][4][2];
typedef f32x4 (&AccMut)[2][2][4][2];

struct Epi1 {
    bf16_t *QS, *KS, *QF, *KF, *VTS, *VTF, *G;
    __device__ __forceinline__ void operator()(AccRef acc, const Unit& u, int wr, int wc, int fr, int fq) const {
        const int pn = u.pn;
        if (pn >= 24) {
            EPI_BEGIN { f32x4 a, b;
#pragma unroll
                for (int e = 0; e < 4; ++e) { a[e] = sigmoidf_(v0[e]); b[e] = sigmoidf_(v1[e]); }
                *(u32x4*)(G + (size_t)row * 4096 + (col - 6144)) = pack8(a, b); } EPI_END
        } else {
            const int t = pn >> 2;
            if (t == 2 || t == 5) {
                bf16_t* VT = (t == 2) ? VTS : VTF;
                EPI_BEGIN { const int c = col - t * 1024; const int hh = c >> 7, d = c & 127; const int b = row >> 12, s = row & 4095;
                    bf16_t* p = VT + ((size_t)((b * 8 + hh) * 128 + d)) * SEQ + s; const u32x4 w = pack8(v0, v1);
                    p[0] = (bf16_t)(w.x & 0xffff); p[SEQ] = (bf16_t)(w.x >> 16); p[2 * SEQ] = (bf16_t)(w.y & 0xffff); p[3 * SEQ] = (bf16_t)(w.y >> 16);
                    p[4 * SEQ] = (bf16_t)(w.z & 0xffff); p[5 * SEQ] = (bf16_t)(w.z >> 16); p[6 * SEQ] = (bf16_t)(w.w & 0xffff); p[7 * SEQ] = (bf16_t)(w.w >> 16); } EPI_END
            } else {
                bf16_t* dst = (t == 0) ? QS : (t == 1) ? KS : (t == 3) ? QF : KF; const float sc = (t == 0 || t == 3) ? QSCALE : 1.f;
                EPI_BEGIN { *(u32x4*)(dst + (size_t)row * 1024 + (col - t * 1024)) = pack8(v0 * sc, v1 * sc); } EPI_END
            }
        }
    }
};
struct EpiBf16Plain { bf16_t* O; int ldc;
    __device__ __forceinline__ void operator()(AccRef acc, const Unit& u, int wr, int wc, int fr, int fq) const {
        EPI_BEGIN { *(u32x4*)(O + (size_t)row * ldc + col) = pack8(v0, v1); } EPI_END } };
struct EpiWeff { bf16_t* O; const float* gain;
    __device__ __forceinline__ void operator()(AccRef acc, const Unit& u, int wr, int wc, int fr, int fq) const {
        EPI_BEGIN { const f32x4 g0 = *(const f32x4*)(gain + col), g1 = *(const f32x4*)(gain + col + 4); *(u32x4*)(O + (size_t)row * DM + col) = pack8(v0 * g0, v1 * g1); } EPI_END } };
struct Epi2 { const bf16_t* G; bf16_t* MG;
    __device__ __forceinline__ void mid(AccMut acc, const Unit& u, int wr, int wc, int fr, int fq) const {
        const int row0 = u.pm * 256 + wr * 64 + fr, col0 = u.pn * 256 + wc * 32 + 8 * fq;
#pragma unroll
        for (int ai = 0; ai < 2; ++ai)
#pragma unroll
            for (int m = 0; m < 4; ++m)
#pragma unroll
                for (int bj = 0; bj < 2; ++bj) {
                    int row = row0 + ai * 128 + m * 16; const int col = col0 + bj * 128; asm volatile("" : "+v"(row));
                    const bf16_t* gp = G + (size_t)row * 4096 + col;
                    const u32x4 g1 = *(const u32x4*)gp, g2 = *(const u32x4*)(gp + 2048);
                    f32x4 ra, rb;
#pragma unroll
                    for (int t = 0; t < 2; ++t) {
                        ra[2 * t] = bflo(g1[t]) * __builtin_amdgcn_rcpf(fmaxf(bflo(g2[t]), 1e-30f)); ra[2 * t + 1] = bfhi(g1[t]) * __builtin_amdgcn_rcpf(fmaxf(bfhi(g2[t]), 1e-30f));
                        rb[2 * t] = bflo(g1[2 + t]) * __builtin_amdgcn_rcpf(fmaxf(bflo(g2[2 + t]), 1e-30f)); rb[2 * t + 1] = bfhi(g1[2 + t]) * __builtin_amdgcn_rcpf(fmaxf(bfhi(g2[2 + t]), 1e-30f));
                    }
                    acc[ai][bj][m][0] = acc[ai][bj][m][0] * ra; acc[ai][bj][m][1] = acc[ai][bj][m][1] * rb;
                }
    }
    __device__ __forceinline__ void operator()(AccRef acc, const Unit& u, int wr, int wc, int fr, int fq) const {
        EPI_BEGIN { const u32x4 gv = *(const u32x4*)(G + (size_t)row * 4096 + 2048 + col);
            f32x4 a = {fmaxf(bflo(gv.x), 1e-30f), fmaxf(bfhi(gv.x), 1e-30f), fmaxf(bflo(gv.y), 1e-30f), fmaxf(bfhi(gv.y), 1e-30f)}, b = {fmaxf(bflo(gv.z), 1e-30f), fmaxf(bfhi(gv.z), 1e-30f), fmaxf(bflo(gv.w), 1e-30f), fmaxf(bfhi(gv.w), 1e-30f)};
            *(u32x4*)(MG + (size_t)row * DM + col) = pack8(v0 * a, v1 * b); } EPI_END
    } };
struct Epi3 { const float* HIN; float* HOUT; bf16_t* XB; float* RS;
    __device__ __forceinline__ void operator()(AccRef acc, const Unit& u, int wr, int wc, int fr, int fq) const {
        const int row0 = u.pm * 256 + wr * 64 + fr, col0 = u.pn * 256 + wc * 32 + 8 * fq;
#pragma unroll
        for (int ai = 0; ai < 2; ++ai)
#pragma unroll
            for (int m = 0; m < 4; ++m) {
                int row = row0 + ai * 128 + m * 16; asm volatile("" : "+v"(row));
                float ssq = 0.f;
#pragma unroll
                for (int bj = 0; bj < 2; ++bj) {
                    const int col = col0 + bj * 128;
                    const float* ip = HIN + (size_t)row * DM + col; float* op = HOUT + (size_t)row * DM + col;
                    const f32x4 h0 = *(const f32x4*)ip + acc[ai][bj][m][0], h1 = *(const f32x4*)(ip + 4) + acc[ai][bj][m][1];
                    *(f32x4*)op = h0; *(f32x4*)(op + 4) = h1;
                    *(u32x4*)(XB + (size_t)row * DM + col) = pack8(h0, h1);
                    ssq += (h0[0] * h0[0] + h0[1] * h0[1]) + (h0[2] * h0[2] + h0[3] * h0[3]) + (h1[0] * h1[0] + h1[1] * h1[1]) + (h1[2] * h1[2] + h1[3] * h1[3]);
                }
                ssq += __shfl_xor(ssq, 16); ssq += __shfl_xor(ssq, 32);
                if (fq == 0) (void)__hip_atomic_fetch_add(RS + row, ssq, __ATOMIC_RELAXED, __HIP_MEMORY_SCOPE_AGENT);
            }
    } };
struct EpiF32 { float* O; const float* RS;
    __device__ __forceinline__ void operator()(AccRef acc, const Unit& u, int wr, int wc, int fr, int fq) const {
        EPI_BEGIN { const float rstd = __builtin_amdgcn_rsqf(RS[row] * (1.f / DM) + EPS); float* op = O + (size_t)row * DM + col; *(f32x4*)op = v0 * rstd; *(f32x4*)(op + 4) = v1 * rstd; } EPI_END } };
struct Epi10 { float* H; const bf16_t* PE;
    __device__ __forceinline__ void operator()(AccRef acc, const Unit& u, int wr, int wc, int fr, int fq) const {
        EPI_BEGIN { const u32x4 pv = *(const u32x4*)(PE + (size_t)row * DM + col);
            f32x4 a = {bflo(pv.x), bfhi(pv.x), bflo(pv.y), bfhi(pv.y)}, b = {bflo(pv.z), bfhi(pv.z), bflo(pv.w), bfhi(pv.w)};
            f32x4 s0, s1;
#pragma unroll
            for (int e = 0; e < 4; ++e) { s0[e] = sigmoidf_(v0[e]); s1[e] = sigmoidf_(v1[e]); }
            float* hp = H + (size_t)row * DM + col; const f32x4 h0 = *(const f32x4*)hp, h1 = *(const f32x4*)(hp + 4);
            *(f32x4*)hp = h0 + s0 * a; *(f32x4*)(hp + 4) = h1 + s1 * b; } EPI_END } };
}

namespace att {
constexpr int KP = 272, VP = 144, KTB = 64 * KP, VTB = 128 * VP, BUFB = KTB + VTB;
constexpr int F2_OFF = 2 * BUFB, FLAG_OFF = F2_OFF + 16384, WT_OFF = FLAG_OFF + 64;
constexpr float NEG_INF = -__builtin_inff();
constexpr float DEAD = -160.f;

#define MFMA32(a, b, c) __builtin_amdgcn_mfma_f32_32x32x16_bf16((a), (b), (c), 0, 0, 0)

template <bool FOX>
__device__ __forceinline__ void item(LAS unsigned char* lds, const bf16_t* Qp, const bf16_t* __restrict__ Kp, const bf16_t* __restrict__ VTp, bf16_t* Op,
                                     const float* __restrict__ LF, const int b, const int h, const int qb) {
    int tid = threadIdx.x; asm volatile("" : "+v"(tid));
    const int wave = __builtin_amdgcn_readfirstlane(tid >> 6), lane = tid & 63, g = lane >> 5, ql = lane & 31;
    const int q0 = qb * 256, myrow0 = q0 + wave * 32, myq = myrow0 + ql;
    const size_t tokbase = (size_t)b * SEQ;
    const bf16_t* Kg = Kp + tokbase * 1024 + h * 128;
    const bf16_t* Vg = VTp + (size_t)((b * 8 + h) * 128) * SEQ;
    const int kr = tid >> 4, kc = tid & 15, vr = tid >> 3, vc = tid & 7;
    u32x4 kreg0, kreg1, vreg0, vreg1;
#define ATT_LOAD(kt) { const bf16_t* kp_ = Kg + (size_t)((kt) * 64 + kr) * 1024 + kc * 8; kreg0 = *(const u32x4*)kp_; kreg1 = *(const u32x4*)(kp_ + 32 * 1024); \
        const bf16_t* vp_ = Vg + (size_t)vr * SEQ + (kt) * 64 + vc * 8; vreg0 = *(const u32x4*)vp_; vreg1 = *(const u32x4*)(vp_ + (size_t)64 * SEQ); }
#define ATT_STORE(buf) { LAS unsigned char* kb_ = lds + (buf) * BUFB; *(LAS u32x4*)(kb_ + kr * KP + kc * 16) = kreg0; *(LAS u32x4*)(kb_ + (kr + 32) * KP + kc * 16) = kreg1; \
        LAS unsigned char* vb_ = kb_ + KTB; *(LAS u32x4*)(vb_ + vr * VP + vc * 16) = vreg0; *(LAS u32x4*)(vb_ + (vr + 64) * VP + vc * 16) = vreg1; }
    const int kt_hi = qb * 4 + 3;
    __syncthreads();
    ATT_LOAD(kt_hi);
    bf16x8 qf[8];
    { const bf16_t* qp = Qp + (tokbase + myq) * 1024 + h * 128 + 8 * g;
#pragma unroll
      for (int kk = 0; kk < 8; ++kk) qf[kk] = *(const bf16x8*)(qp + 16 * kk); }
    LAS float* F2 = (LAS float*)(lds + F2_OFF);
    LAS int* flags = (LAS int*)(lds + FLAG_OFF);
    LAS float* WT = (LAS float*)(lds + WT_OFF);
    if (tid < 16) flags[tid] = 0;
    if (FOX) {
        const float* lf = LF + (size_t)(b * 8 + h) * SEQ + 8 * tid;
        const f32x4 a = *(const f32x4*)lf, c = *(const f32x4*)(lf + 4);
        float p[8]; p[0] = a[0]; p[1] = p[0] + a[1]; p[2] = p[1] + a[2]; p[3] = p[2] + a[3]; p[4] = p[3] + c[0]; p[5] = p[4] + c[1]; p[6] = p[5] + c[2]; p[7] = p[6] + c[3];
        float sc = p[7];
#pragma unroll
        for (int off = 1; off < 64; off <<= 1) { const float t = __shfl_up(sc, off); if (lane >= off) sc += t; }
        if (lane == 63) WT[wave] = sc;
        __syncthreads();
        float base = sc - p[7];
        for (int w = 0; w < wave; ++w) base += WT[w];
        *(LAS f32x4*)(F2 + 8 * tid) = (f32x4){base + p[0], base + p[1], base + p[2], base + p[3]};
        *(LAS f32x4*)(F2 + 8 * tid + 4) = (f32x4){base + p[4], base + p[5], base + p[6], base + p[7]};
    }
    ATT_STORE(0);
    __syncthreads();
    const int kl = 16 * (ql >> 4) + 8 * ((ql >> 2) & 1) + 4 * ((ql >> 3) & 1) + (ql & 3);
    const int koff = kl * KP + 16 * g;
    const int voff = KTB + ql * VP + 16 * g;
    f32x16 o[4];
#pragma unroll
    for (int d = 0; d < 4; ++d)
#pragma unroll
        for (int i = 0; i < 16; ++i) o[d][i] = 0.f;
    float carry = 0.f;
    float m_run = NEG_INF, l_run = 0.f;
    int it = 0;
    for (int kt = kt_hi; kt >= 0; --kt, ++it) {
        const int cur = it & 1;
        if (kt > 0) ATT_LOAD(kt - 1);
        if (!FOX && it > 0) {
            int alldead = 1;
#pragma unroll
            for (int w = 0; w < 8; ++w) alldead &= flags[((it - 1) & 1) * 8 + w];
            if (alldead) break;
        }
        LAS const unsigned char* buf = lds + cur * BUFB;
        const int k0 = kt * 64;
#pragma unroll
        for (int kb2 = 1; kb2 >= 0; --kb2) {
            const int kbase = k0 + 32 * kb2;
            const bool skip = FOX ? (kbase > myrow0 + 31) : (kbase >= myrow0 + 31);
            if (skip) continue;
            const bool need_mask = FOX ? (kbase + 31 > myrow0) : (kbase + 31 >= myrow0);
            f32x16 s;
#pragma unroll
            for (int i = 0; i < 16; ++i) s[i] = 0.f;
            { LAS const unsigned char* kb = buf + kb2 * 32 * KP + koff;
#pragma unroll
              for (int kk = 0; kk < 8; ++kk) { const bf16x8 kf = *(LAS const bf16x8*)(kb + 32 * kk); s = MFMA32(kf, qf[kk], s); } }
            const int sp0 = kbase + 8 * g;
            float pr[16];
            if (!FOX) {
                float l1m[16], lb[16];
#pragma unroll
                for (int i = 0; i < 16; ++i) {
                    const float y = s[i];
                    const float sp2 = fmaxf(y, 0.f) + __builtin_amdgcn_logf(1.f + __builtin_amdgcn_exp2f(-fabsf(y)));
                    const bool valid = !need_mask || (sp0 + 16 * (i >> 3) + (i & 7) < myq);
                    l1m[i] = valid ? -sp2 : 0.f; lb[i] = valid ? (y - sp2) : NEG_INF;
                }
                float aft[16], R0 = 0.f, R1 = 0.f;
#pragma unroll
                for (int e = 7; e >= 0; --e) { aft[e] = R0; R0 += l1m[e]; aft[8 + e] = R1; R1 += l1m[8 + e]; }
                const float P0 = __shfl_xor(R0, 32), P1 = __shfl_xor(R1, 32);
                const float off1 = carry + (g ? 0.f : P1);
                const float off0 = carry + (g ? (R1 + P1) : (P1 + R1 + P0));
#pragma unroll
                for (int i = 0; i < 16; ++i) pr[i] = __builtin_amdgcn_exp2f(lb[i] + aft[i] + (i < 8 ? off0 : off1));
                carry += (R0 + R1) + (P0 + P1);
            } else {
                float y2[16];
#pragma unroll
                for (int c = 0; c < 2; ++c) {
                    const f32x4 fa = *(LAS const f32x4*)(F2 + sp0 + 16 * c), fb = *(LAS const f32x4*)(F2 + sp0 + 16 * c + 4);
#pragma unroll
                    for (int e = 0; e < 4; ++e) { y2[8 * c + e] = s[8 * c + e] - fa[e]; y2[8 * c + 4 + e] = s[8 * c + 4 + e] - fb[e]; }
                }
                if (need_mask) {
#pragma unroll
                    for (int i = 0; i < 16; ++i) y2[i] = (sp0 + 16 * (i >> 3) + (i & 7) <= myq) ? y2[i] : NEG_INF;
                }
                float bm = y2[0];
#pragma unroll
                for (int i = 1; i < 16; ++i) bm = fmaxf(bm, y2[i]);
                bm = fmaxf(bm, __shfl_xor(bm, 32));
                const float mn = fmaxf(m_run, bm);
                const float ms = (mn == NEG_INF) ? 0.f : mn;
                const float alpha = __builtin_amdgcn_exp2f(m_run - ms);
                float rs = 0.f;
#pragma unroll
                for (int i = 0; i < 16; ++i) { pr[i] = __builtin_amdgcn_exp2f(y2[i] - ms); rs += pr[i]; }
                l_run = l_run * alpha + rs; m_run = mn;
                if (__builtin_amdgcn_ballot_w64(alpha != 1.f) != 0ull) {
#pragma unroll
                    for (int d = 0; d < 4; ++d)
#pragma unroll
                        for (int i = 0; i < 16; ++i) o[d][i] *= alpha;
                }
            }
            bf16x8 pc0, pc1;
            { const u32x4 w0 = pack8((f32x4){pr[0], pr[1], pr[2], pr[3]}, (f32x4){pr[4], pr[5], pr[6], pr[7]});
              const u32x4 w1 = pack8((f32x4){pr[8], pr[9], pr[10], pr[11]}, (f32x4){pr[12], pr[13], pr[14], pr[15]});
              pc0 = __builtin_bit_cast(bf16x8, w0); pc1 = __builtin_bit_cast(bf16x8, w1); }
            { LAS const unsigned char* vb = buf + voff + kb2 * 64;
#pragma unroll
              for (int d = 0; d < 4; ++d) {
                  const bf16x8 vf0 = *(LAS const bf16x8*)(vb + d * 32 * VP), vf1 = *(LAS const bf16x8*)(vb + d * 32 * VP + 32);
                  o[d] = MFMA32(vf0, pc0, o[d]); o[d] = MFMA32(vf1, pc1, o[d]);
              } }
        }
        if (!FOX) { const int dead = (__builtin_amdgcn_ballot_w64(carry < DEAD) == ~0ull) ? 1 : 0; if (lane == 0) flags[cur * 8 + wave] = dead; }
        if (kt > 0) ATT_STORE(cur ^ 1);
        __syncthreads();
    }
    if (FOX) {
        const float lt = l_run + __shfl_xor(l_run, 32);
        const float inv = 1.f / lt;
#pragma unroll
        for (int d = 0; d < 4; ++d)
#pragma unroll
            for (int i = 0; i < 16; ++i) o[d][i] *= inv;
    }
    { bf16_t* op = Op + (tokbase + myq) * 2048 + h * 128 + 4 * g;
#pragma unroll
      for (int d = 0; d < 4; ++d)
#pragma unroll
          for (int a = 0; a < 4; ++a) {
              u32x2 w; w.x = cvt_pk_bf16(o[d][4 * a], o[d][4 * a + 1]); w.y = cvt_pk_bf16(o[d][4 * a + 2], o[d][4 * a + 3]);
              *(u32x2*)(op + 32 * d + 8 * a) = w;
          } }
#undef ATT_LOAD
#undef ATT_STORE
}
}

namespace peer {
__device__ __forceinline__ unsigned ord_key(float f) { const unsigned u = __builtin_bit_cast(unsigned, f); return (u & 0x80000000u) ? ~u : (u | 0x80000000u); }
__device__ __forceinline__ float ord_val(unsigned k) { const unsigned u = (k & 0x80000000u) ? (k & 0x7fffffffu) : ~k; return __builtin_bit_cast(float, u); }
template <int C> __device__ __forceinline__ unsigned dppu(unsigned v) { return (unsigned)__builtin_amdgcn_update_dpp(0, (int)v, C, 0xF, 0xF, false); }
template <int C> __device__ __forceinline__ float dppf(float v) { return __builtin_bit_cast(float, __builtin_amdgcn_update_dpp(0, __builtin_bit_cast(int, v), C, 0xF, 0xF, false)); }
__device__ __forceinline__ unsigned umax_(unsigned a, unsigned b) { return a > b ? a : b; }
#ifndef PEER_NO_DPP
__device__ __forceinline__ unsigned rowmax_u(unsigned v) { v = umax_(v, dppu<0x128>(v)); v = umax_(v, dppu<0x124>(v)); v = umax_(v, dppu<0x122>(v)); v = umax_(v, dppu<0x121>(v)); return v; }
__device__ __forceinline__ float rowsum_f(float v) { v += dppf<0x128>(v); v += dppf<0x124>(v); v += dppf<0x122>(v); v += dppf<0x121>(v); return v; }
#else
__device__ __forceinline__ unsigned rowmax_u(unsigned v) { v = umax_(v, (unsigned)__shfl_xor((int)v, 8)); v = umax_(v, (unsigned)__shfl_xor((int)v, 4)); v = umax_(v, (unsigned)__shfl_xor((int)v, 2)); v = umax_(v, (unsigned)__shfl_xor((int)v, 1)); return v; }
__device__ __forceinline__ float rowsum_f(float v) { v += __shfl_xor(v, 8); v += __shfl_xor(v, 4); v += __shfl_xor(v, 2); v += __shfl_xor(v, 1); return v; }
#endif

__device__ __forceinline__ float dot8(u32x4 a, u32x4 b, float d) {
#pragma unroll
#ifdef PEER_FDOT2
    for (int t = 0; t < 4; ++t) d = __builtin_amdgcn_fdot2_f32_bf16(__builtin_bit_cast(bf16v2, a[t]), __builtin_bit_cast(bf16v2, b[t]), d, false);
#else
    for (int t = 0; t < 4; ++t) { d += bflo(a[t]) * bflo(b[t]); d += bfhi(a[t]) * bfhi(b[t]); }
#endif
    return d;
}

__device__ __forceinline__ void token(LAS unsigned char* wlds, const float* __restrict__ SC, const bf16_t* __restrict__ XIN, bf16_t* XN, float* H, const unsigned char* __restrict__ EU, const unsigned char* __restrict__ EV, const float* __restrict__ SU, const float* __restrict__ SV, const float* __restrict__ RS, const int m, const int lane_in, const bool dry = false) {
    int lane = lane_in; asm volatile("" : "+v"(lane));
    LAS int* widx = (LAS int*)wlds;
    LAS float* wgate = (LAS float*)(wlds + 512);
    LAS float* wcoef = (LAS float*)(wlds + 1024);
    const int r = lane >> 4, l16 = lane & 15, pp = r & 1;
#pragma unroll 1
    for (int rd = 0; rd < 4; ++rd) {
        const float* sp = SC + (size_t)m * 2048 + (4 * rd + r) * 128 + l16 * 8;
        const f32x4 a = *(const f32x4*)sp, c = *(const f32x4*)(sp + 4);
        unsigned key[8];
#pragma unroll
        for (int e = 0; e < 4; ++e) { key[e] = (ord_key(a[e]) & ~0xFFu) | (unsigned)(255 - (l16 * 8 + e)); key[4 + e] = (ord_key(c[e]) & ~0xFFu) | (unsigned)(255 - (l16 * 8 + 4 + e)); }
#define PEER_CE(i, j) { const unsigned hi_ = umax_(key[i], key[j]), lo_ = key[i] < key[j] ? key[i] : key[j]; key[i] = hi_; key[j] = lo_; }
        PEER_CE(0, 1) PEER_CE(2, 3) PEER_CE(4, 5) PEER_CE(6, 7) PEER_CE(0, 2) PEER_CE(1, 3) PEER_CE(4, 6) PEER_CE(5, 7) PEER_CE(1, 2) PEER_CE(5, 6) PEER_CE(0, 4) PEER_CE(3, 7)
        PEER_CE(1, 5) PEER_CE(2, 6) PEER_CE(1, 4) PEER_CE(3, 6) PEER_CE(2, 4) PEER_CE(3, 5) PEER_CE(3, 4)
#undef PEER_CE
        unsigned mine = 0u;
#pragma unroll 1
        for (int itn = 0; itn < 16; ++itn) {
            const unsigned rm = rowmax_u(key[0]);
            const bool won = (key[0] == rm);
            mine = (l16 == itn) ? rm : mine;
#pragma unroll
            for (int e = 0; e < 7; ++e) key[e] = won ? key[e + 1] : key[e];
            key[7] = won ? 0u : key[7];
        }
        const float myv = ord_val(mine & ~0xFFu);
        const float s1 = __shfl(myv, (lane & 32) | l16);
        unsigned ck[8];
#pragma unroll
        for (int e = 0; e < 8; ++e) { const float s2 = __shfl(myv, (lane & 32) + 16 + 8 * pp + e); ck[e] = (ord_key(s1 + s2) & ~0xFFu) | (unsigned)(255 - (l16 * 16 + 8 * pp + e)); }
        unsigned sel = 0u;
#pragma unroll 1
        for (int itn = 0; itn < 16; ++itn) {
            unsigned rm = rowmax_u(ck[0]);
            rm = umax_(rm, (unsigned)__shfl_xor((int)rm, 16));
            const bool won = (ck[0] == rm);
            sel = (l16 == itn) ? rm : sel;
#pragma unroll
            for (int e = 0; e < 7; ++e) ck[e] = won ? ck[e + 1] : ck[e];
            ck[7] = won ? 0u : ck[7];
        }
        const float tv = ord_val(sel & ~0xFFu); const int cidx = 255 - (int)(sel & 0xFFu); const int ci = cidx >> 4, cj = cidx & 15;
        const unsigned k1 = (unsigned)__shfl((int)mine, (lane & 32) | ci), k2 = (unsigned)__shfl((int)mine, (lane & 32) + 16 + cj);
        const int expert = (255 - (int)(k1 & 0xFFu)) * 128 + (255 - (int)(k2 & 0xFFu));
        const float mx = ord_val(rowmax_u(sel) & ~0xFFu);
        const float ex = __expf(tv - mx);
        const float gate = ex / rowsum_f(ex);
        if (pp == 0) { const int slot = (2 * rd + (r >> 1)) * 16 + l16; widx[slot] = expert; wgate[slot] = gate; }
    }
    __builtin_amdgcn_wave_barrier(); asm volatile("s_waitcnt lgkmcnt(0)" ::: "memory");
    asm volatile("" : "+v"(lane));
    f32x2 xf[16];
    { const u32x4* xp = (const u32x4*)(XIN + (size_t)m * DM + 32 * lane);
#pragma unroll
      for (int c = 0; c < 4; ++c) { const u32x4 w = xp[c];
#pragma unroll
          for (int t = 0; t < 4; ++t) xf[4 * c + t] = (f32x2){bflo(w[t]), bfhi(w[t])}; } }
#if PEER_FP4
    u32x4 bA[8], bB[8];
#define PEER_LOAD(buf, grp, TABLE) { _Pragma("unroll") for (int e = 0; e < 8; ++e) { const int id = __builtin_amdgcn_readfirstlane(widx[(grp) * 8 + e]); \
        buf[e] = *(const u32x4*)((TABLE) + (size_t)id * ROWB + 16 * lane); } }
#define PEER_DOT(buf, base) { _Pragma("unroll") for (int e = 0; e < 8; ++e) { f32x2 d2 = {0.f, 0.f}; \
        _Pragma("unroll") for (int q = 0; q < 4; ++q) { const unsigned w = buf[e][q]; \
            d2 = d2 + __builtin_amdgcn_cvt_scalef32_pk_f32_fp4(w, 1.0f, 0) * xf[4 * q]; d2 = d2 + __builtin_amdgcn_cvt_scalef32_pk_f32_fp4(w, 1.0f, 1) * xf[4 * q + 1]; \
            d2 = d2 + __builtin_amdgcn_cvt_scalef32_pk_f32_fp4(w, 1.0f, 2) * xf[4 * q + 2]; d2 = d2 + __builtin_amdgcn_cvt_scalef32_pk_f32_fp4(w, 1.0f, 3) * xf[4 * q + 3]; } \
        part[(base) + e] = d2.x + d2.y; } }
#else
    v6u bA[8], bB[8];
#define PEER_LOAD(buf, grp, TABLE) { _Pragma("unroll") for (int e = 0; e < 8; ++e) { const int id = __builtin_amdgcn_readfirstlane(widx[(grp) * 8 + e]); \
        const unsigned char* rp = (TABLE) + (size_t)id * ROWB + 24 * lane; const u32x4 w4 = *(const u32x4*)rp; const u32x2 w2 = *(const u32x2*)(rp + 16); \
        buf[e] = (v6u){w4[0], w4[1], w4[2], w4[3], w2[0], w2[1]}; } }
#define PEER_DOT(buf, base) { _Pragma("unroll") for (int e = 0; e < 8; ++e) { const v32f r = __builtin_amdgcn_cvt_scalef32_pk32_f32_fp6(buf[e], 1.0f); f32x2 d2 = {0.f, 0.f}; \
        _Pragma("unroll") for (int i = 0; i < 16; ++i) d2 = d2 + (f32x2){r[2 * i], r[2 * i + 1]} * xf[i]; part[(base) + e] = d2.x + d2.y; } }
#endif
    const float rstd_in = __builtin_amdgcn_rsqf(RS[m] * (1.f / DM) + EPS);
    PEER_LOAD(bA, 0, EU);
#pragma unroll 1
    for (int hd = 0; hd < 8; ++hd) {
        float part[16];
        const int myid = widx[hd * 16 + (lane & 15)];
        const float su = SU[myid], sv = SV[myid];
        PEER_LOAD(bB, 2 * hd + 1, EU); PEER_DOT(bA, 0); __builtin_amdgcn_sched_barrier(0);
        { const int gn = min(2 * hd + 2, 15); PEER_LOAD(bA, gn, EU); } PEER_DOT(bB, 8); __builtin_amdgcn_sched_barrier(0);
        float r8[8], r4[4], r2[2], r1;
        { const bool b0 = lane & 1;
#pragma unroll
          for (int t = 0; t < 8; ++t) { const float keep = b0 ? part[2 * t + 1] : part[2 * t], send = b0 ? part[2 * t] : part[2 * t + 1]; r8[t] = keep + __shfl_xor(send, 1); } }
        { const bool b1 = lane & 2;
#pragma unroll
          for (int t = 0; t < 4; ++t) { const float keep = b1 ? r8[2 * t + 1] : r8[2 * t], send = b1 ? r8[2 * t] : r8[2 * t + 1]; r4[t] = keep + __shfl_xor(send, 2); } }
        { const bool b2 = lane & 4;
#pragma unroll
          for (int t = 0; t < 2; ++t) { const float keep = b2 ? r4[2 * t + 1] : r4[2 * t], send = b2 ? r4[2 * t] : r4[2 * t + 1]; r2[t] = keep + __shfl_xor(send, 4); } }
        { const bool b3 = lane & 8; const float keep = b3 ? r2[1] : r2[0], send = b3 ? r2[0] : r2[1]; r1 = keep + __shfl_xor(send, 8); }
        r1 += __shfl_xor(r1, 16); r1 += __shfl_xor(r1, 32);
        r1 *= su * rstd_in;
        const float hid = 0.5f * r1 * (1.f + erff(r1 * 0.70710678118654752f));
        if (lane < 16) wcoef[hd * 16 + lane] = wgate[hd * 16 + lane] * hid * sv;
    }
    __builtin_amdgcn_wave_barrier(); asm volatile("s_waitcnt lgkmcnt(0)" ::: "memory");
    asm volatile("" : "+v"(lane));
    f32x2 acc2[16];
#pragma unroll
    for (int i = 0; i < 16; ++i) acc2[i] = (f32x2){0.f, 0.f};
#if PEER_FP4
#define PEER_FMA(buf, grp) { _Pragma("unroll") for (int e = 0; e < 8; ++e) { const float cf = wcoef[(grp) * 8 + e]; const f32x2 cf2 = {cf, cf}; \
        _Pragma("unroll") for (int q = 0; q < 4; ++q) { const unsigned w = buf[e][q]; \
            acc2[4 * q] = acc2[4 * q] + cf2 * __builtin_amdgcn_cvt_scalef32_pk_f32_fp4(w, 1.0f, 0); acc2[4 * q + 1] = acc2[4 * q + 1] + cf2 * __builtin_amdgcn_cvt_scalef32_pk_f32_fp4(w, 1.0f, 1); \
            acc2[4 * q + 2] = acc2[4 * q + 2] + cf2 * __builtin_amdgcn_cvt_scalef32_pk_f32_fp4(w, 1.0f, 2); acc2[4 * q + 3] = acc2[4 * q + 3] + cf2 * __builtin_amdgcn_cvt_scalef32_pk_f32_fp4(w, 1.0f, 3); } } }
#else
#define PEER_FMA(buf, grp) { _Pragma("unroll") for (int e = 0; e < 8; ++e) { const float cf = wcoef[(grp) * 8 + e]; const f32x2 cf2 = {cf, cf}; const v32f r = __builtin_amdgcn_cvt_scalef32_pk32_f32_fp6(buf[e], 1.0f); \
        _Pragma("unroll") for (int i = 0; i < 16; ++i) acc2[i] = acc2[i] + cf2 * (f32x2){r[2 * i], r[2 * i + 1]}; } }
#endif
    PEER_LOAD(bA, 0, EV);
#pragma unroll 1
    for (int gp = 0; gp < 8; ++gp) {
        PEER_LOAD(bB, 2 * gp + 1, EV); PEER_FMA(bA, 2 * gp); __builtin_amdgcn_sched_barrier(0);
        { const int gn = min(2 * gp + 2, 15); PEER_LOAD(bA, gn, EV); } PEER_FMA(bB, 2 * gp + 1); __builtin_amdgcn_sched_barrier(0);
    }
    float ss = 0.f;
    float* hp = H + (size_t)m * DM + 32 * lane;
#pragma unroll
    for (int q = 0; q < 8; ++q) {
        f32x4 h0 = *(const f32x4*)(hp + 4 * q);
        h0[0] += acc2[2 * q].x; h0[1] += acc2[2 * q].y; h0[2] += acc2[2 * q + 1].x; h0[3] += acc2[2 * q + 1].y;
        acc2[2 * q] = (f32x2){h0[0], h0[1]}; acc2[2 * q + 1] = (f32x2){h0[2], h0[3]};
        ss += (h0[0] * h0[0] + h0[1] * h0[1]) + (h0[2] * h0[2] + h0[3] * h0[3]);
        if (!dry || ss == 12345.678f) *(f32x4*)(hp + 4 * q) = h0;
    }
    const float rstd = __builtin_amdgcn_rsqf(wave_sum(ss) * (1.f / DM) + EPS);
    { u32x4* xo = (u32x4*)(XN + (size_t)m * DM + 32 * lane);
#pragma unroll
      for (int c = 0; c < 4; ++c) { u32x4 w;
#pragma unroll
          for (int t = 0; t < 4; ++t) w[t] = cvt_pk_bf16(acc2[4 * c + t].x * rstd, acc2[4 * c + t].y * rstd);
          if (!dry || ss == 12345.678f) xo[c] = w; } }
#undef PEER_LOAD
#undef PEER_DOT
#undef PEER_FMA
}
}


#define XB_TMO      128
#define XB_XCNT(j)  (256  + 64 * (j))
#define XB_XSUB(j)  (1280 + 64 * (j))
#define XB_XGEN(j)  (2304 + 64 * (j))
#define XB_TOP      3328
#define XB_TOPGEN   3392
#define XCD_BAR_WORDS 3456
#define XB_SPIN_CAP (1u << 22)
__device__ __forceinline__ unsigned xb_ld(unsigned* p)              { return __hip_atomic_load(p, __ATOMIC_RELAXED, __HIP_MEMORY_SCOPE_AGENT); }
__device__ __forceinline__ unsigned xb_add(unsigned* p, unsigned v) { return __hip_atomic_fetch_add(p, v, __ATOMIC_RELAXED, __HIP_MEMORY_SCOPE_AGENT); }
__device__ __forceinline__ unsigned xb_xcc_id() { return (unsigned)__builtin_amdgcn_s_getreg((3 << 11) | 20) & 0xFu; }
#define XB_SPIN(cond, bar) do { unsigned _sp = 0; while (cond) { __builtin_amdgcn_s_sleep(1); \
    if ((++_sp & 255u) == 0u) { if (xb_ld(&(bar)[XB_TMO])) break; if (_sp > XB_SPIN_CAP) { atomicAdd(&(bar)[XB_TMO], 1u); break; } } } } while (0)
struct XcdBarrier { unsigned* bar; unsigned x; volatile LAS unsigned* st; };
__device__ __forceinline__ XcdBarrier xcd_barrier_post(unsigned* bar, volatile LAS unsigned* st) {
    XcdBarrier b; b.bar = bar; b.x = xb_xcc_id(); b.st = st;
    if (threadIdx.x == 0) (void)xb_add(&bar[XB_XCNT(b.x)], 1u);
    return b;
}
__device__ __forceinline__ void xcd_barrier_complete(unsigned* bar, unsigned x, unsigned& nloc, unsigned& nx) {
    const unsigned G = gridDim.x * gridDim.y * gridDim.z;
    unsigned sum, cnt, mine, sp = 0u;
    for (;;) {
        sum = 0u; cnt = 0u; mine = 0u;
#pragma unroll
        for (unsigned j = 0; j < 16; ++j) { const unsigned c = xb_ld(&bar[XB_XCNT(j)]); sum += c; cnt += (c > 0u) ? 1u : 0u; mine = (j == x) ? c : mine; }
        if (sum == G) break;
        __builtin_amdgcn_s_sleep(1);
        if ((++sp & 255u) == 0u) { if (xb_ld(&bar[XB_TMO])) break; if (sp > XB_SPIN_CAP) { atomicAdd(&bar[XB_TMO], 1u); break; } }
    }
    nloc = mine > 0u ? mine : 1u; nx = cnt > 0u ? cnt : 1u;
}
__device__ __forceinline__ void xcd_barrier(const XcdBarrier& b) {
    asm volatile("s_waitcnt vmcnt(0)" ::: "memory");
    __syncthreads();
    if (threadIdx.x == 0) {
        unsigned* bar = b.bar;
        __builtin_amdgcn_s_waitcnt(0);
        unsigned nloc = b.st[0], nx = b.st[1];
        if (nloc == 0u) { xcd_barrier_complete(bar, b.x, nloc, nx); b.st[0] = nloc; b.st[1] = nx; }
        const unsigned old = xb_add(&bar[XB_XSUB(b.x)], 1u);
        const unsigned gen = old / nloc;
        if (old + 1u == (gen + 1u) * nloc) {
            __builtin_amdgcn_fence(__ATOMIC_RELEASE, "agent");
            asm volatile("s_waitcnt vmcnt(0)" ::: "memory");
            const unsigned og = xb_add(&bar[XB_TOP], 1u);
            const unsigned tg = og / nx;
            if (og + 1u == (tg + 1u) * nx) xb_add(&bar[XB_TOPGEN], 1u);
            else XB_SPIN(xb_ld(&bar[XB_TOPGEN]) == tg, bar);
            __builtin_amdgcn_fence(__ATOMIC_ACQUIRE, "agent");
            xb_add(&bar[XB_XGEN(b.x)], 1u);
            asm volatile("s_waitcnt vmcnt(0)" ::: "memory");
        } else {
            XB_SPIN(xb_ld(&bar[XB_XGEN(b.x)]) == gen, bar);
            __builtin_amdgcn_fence(__ATOMIC_ACQUIRE, "agent");
            asm volatile("s_waitcnt vmcnt(0)" ::: "memory");
        }
    }
    __syncthreads();
}

constexpr size_t MiB = 1u << 20;
constexpr size_t WS_H = 0;
constexpr size_t WS_XN = 128 * MiB;
constexpr size_t WS_QS = 192 * MiB, WS_KS = 224 * MiB, WS_QF = 256 * MiB, WS_KF = 288 * MiB;
constexpr size_t WS_VTS = 320 * MiB, WS_VTF = 352 * MiB;
constexpr size_t WS_G = 384 * MiB;
constexpr size_t WS_T1 = 512 * MiB;
constexpr size_t WS_PE = 640 * MiB;
constexpr size_t WS_EU = 704 * MiB, WS_EV = 768 * MiB;
constexpr size_t WS_W1T = 832 * MiB;
constexpr size_t WS_WBS = 872 * MiB, WS_WBF = 876 * MiB;
constexpr size_t WS_WOT = 880 * MiB;
constexpr size_t WS_WQB = 888 * MiB;
constexpr size_t WS_WEFF = 896 * MiB;
constexpr size_t WS_WPGT = 904 * MiB;
constexpr size_t WS_WPLT = 912 * MiB;
constexpr size_t WS_SKP = 913 * MiB;
constexpr size_t WS_PB = 914 * MiB;
constexpr size_t WS_LF = 922 * MiB;
constexpr size_t WS_SU = 923 * MiB, WS_SV = WS_SU + 65536;
constexpr size_t WS_OS = 924 * MiB, WS_OF = 956 * MiB;
constexpr size_t WS_CTL = 988 * MiB, CTL_BYTES = 65536;
constexpr size_t WS_RS = 989 * MiB;
constexpr size_t WS_END = 990 * MiB;

struct Args { const float* in[17]; float* out; unsigned char* ws; int ph_lo, ph_hi; };

__device__ __forceinline__ void transpose_item(const float* __restrict__ W, int ldw, int c0, int k0, const float* __restrict__ scale, bf16_t* WT, int ldt, int drow0, LAS float* scr, int lane) {
#pragma unroll 8
    for (int i = 0; i < 32; ++i) { const int kk = 2 * i + (lane >> 5); float v = W[(size_t)(k0 + kk) * ldw + c0 + (lane & 31)]; if (scale) v *= scale[k0 + kk]; scr[kk * 33 + (lane & 31)] = v; }
    asm volatile("s_waitcnt lgkmcnt(0)" ::: "memory");
    const int c = lane & 7;
#pragma unroll
    for (int j = 0; j < 4; ++j) { const int n = (lane >> 3) + 8 * j; const LAS float* s = scr + (8 * c) * 33 + n;
        u32x4 o; o.x = cvt_pk_bf16(s[0 * 33], s[1 * 33]); o.y = cvt_pk_bf16(s[2 * 33], s[3 * 33]); o.z = cvt_pk_bf16(s[4 * 33], s[5 * 33]); o.w = cvt_pk_bf16(s[6 * 33], s[7 * 33]);
        *(u32x4*)(WT + (size_t)(drow0 + n) * ldt + k0 + 8 * c) = o; }
    asm volatile("s_waitcnt lgkmcnt(0)" ::: "memory");
}
__device__ __forceinline__ float fp6_val(int c) { return c < 8 ? 0.125f * c : c < 16 ? 1.f + 0.125f * (c - 8) : c < 24 ? 2.f + 0.25f * (c - 16) : 4.f + 0.5f * (c - 24); }
__device__ __forceinline__ int fp6_code(float v) { return v < 1.f ? (int)(v * 8.f + 0.5f) : v < 2.f ? 8 + (int)((v - 1.f) * 8.f + 0.5f) : v < 4.f ? 16 + (int)((v - 2.f) * 4.f + 0.5f) : 24 + (int)((v - 4.f) * 2.f + 0.5f); }
__device__ __forceinline__ void fp6_probe(LAS int* wl, LAS int* posl) {
    float z = 0.f; asm volatile("" : "+v"(z));
    v16f px, py;
#pragma unroll
    for (int i = 0; i < 16; ++i) { px[i] = fp6_val(i) + z; py[i] = fp6_val(16 + i) + z; }
    const v6u pk = __builtin_amdgcn_cvt_scalef32_2xpk16_fp6_f32(px, py, 1.0f);
    const v32f pr = __builtin_amdgcn_cvt_scalef32_pk32_f32_fp6(pk, 1.0f);
#pragma unroll
    for (int k = 0; k < 32; ++k) wl[fp6_code(pr[k]) & 31] = k;
    asm volatile("s_waitcnt lgkmcnt(0)" ::: "memory");
    (void)posl;
}
__device__ __forceinline__ void quant_row_fp6(const float* __restrict__ src, const float* __restrict__ colscale, unsigned char* dst, float* rscale, int row, int lane, LAS float* stage, LAS const int* pos) {
    const float* rp = src + (size_t)row * DM + 32 * lane;
    f32x4 v[8]; float amax = 0.f;
#pragma unroll
    for (int q = 0; q < 8; ++q) { f32x4 t = *(const f32x4*)(rp + 4 * q); if (colscale) t = t * *(const f32x4*)(colscale + 32 * lane + 4 * q);
        v[q] = t; amax = fmaxf(fmaxf(amax, fmaxf(fabsf(t[0]), fabsf(t[1]))), fmaxf(fabsf(t[2]), fabsf(t[3]))); }
#pragma unroll
    for (int o = 1; o < 64; o <<= 1) amax = fmaxf(amax, __shfl_xor(amax, o));
    const float inv = amax > 0.f ? 7.25f / amax : 0.f;
    LAS float* my = stage + lane * 33;
#pragma unroll
    for (int q = 0; q < 8; ++q) { my[4 * q] = v[q][0] * inv; my[4 * q + 1] = v[q][1] * inv; my[4 * q + 2] = v[q][2] * inv; my[4 * q + 3] = v[q][3] * inv; }
    asm volatile("s_waitcnt lgkmcnt(0)" ::: "memory");
    v16f ex, ey;
#pragma unroll
    for (int j = 0; j < 16; ++j) { ex[j] = my[pos[j]]; ey[j] = my[pos[16 + j]]; }
    asm volatile("s_waitcnt lgkmcnt(0)" ::: "memory");
    const v6u pk = __builtin_amdgcn_cvt_scalef32_2xpk16_fp6_f32(ex, ey, 1.0f);
    u32x2* dp = (u32x2*)(dst + (size_t)row * ROWB + 24 * lane);
    dp[0] = (u32x2){pk[0], pk[1]}; dp[1] = (u32x2){pk[2], pk[3]}; dp[2] = (u32x2){pk[4], pk[5]};
    if (lane == 0) rscale[row] = amax * (1.f / 7.25f);
}
__device__ __forceinline__ void quant_row_fp4(const float* __restrict__ src, const float* __restrict__ colscale, unsigned char* dst, float* rscale, int row, int lane) {
    const float* rp = src + (size_t)row * DM + 32 * lane;
    f32x4 v[8]; float amax = 0.f;
#pragma unroll
    for (int q = 0; q < 8; ++q) { f32x4 t = *(const f32x4*)(rp + 4 * q); if (colscale) t = t * *(const f32x4*)(colscale + 32 * lane + 4 * q);
        v[q] = t; amax = fmaxf(fmaxf(amax, fmaxf(fabsf(t[0]), fabsf(t[1]))), fmaxf(fabsf(t[2]), fabsf(t[3]))); }
#pragma unroll
    for (int o = 1; o < 64; o <<= 1) amax = fmaxf(amax, __shfl_xor(amax, o));
    const float inv = amax > 0.f ? 6.f / amax : 0.f;
    u32x4 w;
#pragma unroll
    for (int q = 0; q < 4; ++q) { const f32x4 a = v[2 * q] * inv, b = v[2 * q + 1] * inv; unsigned p = 0u;
        p = __builtin_amdgcn_cvt_scalef32_pk_fp4_f32(p, a[0], a[1], 1.0f, 0); p = __builtin_amdgcn_cvt_scalef32_pk_fp4_f32(p, a[2], a[3], 1.0f, 1);
        p = __builtin_amdgcn_cvt_scalef32_pk_fp4_f32(p, b[0], b[1], 1.0f, 2); p = __builtin_amdgcn_cvt_scalef32_pk_fp4_f32(p, b[2], b[3], 1.0f, 3); w[q] = p; }
    *(u32x4*)(dst + (size_t)row * ROWB + 16 * lane) = w;
    if (lane == 0) rscale[row] = amax * (1.f / 6.f);
}
__device__ __forceinline__ void convert_flat(const float* __restrict__ src, bf16_t* dst, size_t n8, const float* __restrict__ scale, size_t gt, size_t ngt) {
    for (size_t i = gt; i < n8; i += ngt) {
        f32x4 a = *(const f32x4*)(src + 8 * i), b = *(const f32x4*)(src + 8 * i + 4);
        if (scale) { const int k = (int)((8 * i) & 2047); a = a * *(const f32x4*)(scale + k); b = b * *(const f32x4*)(scale + k + 4); }
        *(u32x4*)(dst + 8 * i) = pack8(a, b);
    }
}

#define PH_BEGIN unsigned char* ws = args.ws; asm volatile("" : "+s"(ws)); int L = Lc; asm volatile("" : "+s"(L)); \
    int tid = threadIdx.x; asm volatile("" : "+v"(tid)); const int lane = tid & 63, wave = __builtin_amdgcn_readfirstlane(tid >> 6); const int G = gridDim.x, bid = blockIdx.x; \
    const int gw = bid * NWAVES + wave, NGW = G * NWAVES; (void)gw; (void)NGW; (void)lane; (void)ws; (void)L;
#define WSP(T, off) ((T*)(ws + (off)))
#define INP(i, stride) (args.in[i] + (size_t)L * (stride))

__device__ __forceinline__ void rms_rows_to_bf16(const float* __restrict__ hsrc, bf16_t* XN, int gw, int NGW, int lane) {
    for (int m = gw; m < M; m += NGW) {
        const float* hr = hsrc + (size_t)m * DM + 4 * lane;
        f32x4 v[8]; float ss = 0.f;
#pragma unroll
        for (int j = 0; j < 8; ++j) { v[j] = *(const f32x4*)(hr + 256 * j); ss += (v[j][0] * v[j][0] + v[j][1] * v[j][1]) + (v[j][2] * v[j][2] + v[j][3] * v[j][3]); }
        const float rstd = __builtin_amdgcn_rsqf(wave_sum(ss) * (1.f / DM) + EPS);
        u32x2* xo = (u32x2*)(XN + (size_t)m * DM) + lane;
#pragma unroll
        for (int j = 0; j < 8; ++j) { v[j] = v[j] * rstd; u32x2 w; w.x = cvt_pk_bf16(v[j][0], v[j][1]); w.y = cvt_pk_bf16(v[j][2], v[j][3]); xo[64 * j] = w; }
    }
}

__global__ void __launch_bounds__(NTHREADS, 2) fwd_kernel(Args args) {
    extern __shared__ __attribute__((aligned(16))) unsigned char lds_raw[];
    LAS unsigned char* lds = (LAS unsigned char*)lds_raw;
    cg::grid_group grid = cg::this_grid();
    const int lo = args.ph_lo, hi = args.ph_hi;
    volatile LAS unsigned* bst = (volatile LAS unsigned*)(lds + LDS_BYTES - 64);
    if (threadIdx.x < 2) bst[threadIdx.x] = 0u;
    __syncthreads();
    const XcdBarrier xbar = xcd_barrier_post((unsigned*)(args.ws + WS_CTL), bst);
#ifndef ONLY_PHASE
#define ONLY_PHASE -1
#endif
#define PH_EN(k) (ONLY_PHASE < 0 || ONLY_PHASE == (k))
#define RUN(p) (lo <= (p) && (p) < hi)
#ifndef REP_SYNC
#define REP_SYNC 1
#endif
#define SEAM(p) do { if ((p) + 1 < hi) { for (int rs_ = 0; rs_ < REP_SYNC; ++rs_) { if (MK_SPLIT == 0 && (p) != 0) xcd_barrier(xbar); else { asm volatile("s_waitcnt vmcnt(0)" ::: "memory"); grid.sync(); } } } } while (0)

#pragma unroll 1
    for (int Lc = 0; Lc < DEPTH; ++Lc) {
        const int P = Lc * 9;

        if (PH_EN(0) && RUN(P + 0)) {
#ifndef REP_P0
#define REP_P0 1
#endif
          for (int rep = 0; rep < REP_P0; ++rep) {
            PH_BEGIN
            const float* g_mix = INP(2, DM); const float* w_in = INP(3, (size_t)DM * INC);
            {
                const float* w_bsb = INP(5, (size_t)1024 * DM); const float* w_bfx = INP(6, (size_t)1024 * DM); const float* w_out = INP(7, (size_t)DM * DM);
                const float* g_ple = INP(13, DM); const float* w_ple = INP(14, (size_t)PLE * DM); const float* w_pg = INP(15, (size_t)DM * DM);
                bf16_t *W1T = WSP(bf16_t, WS_W1T), *WBS = WSP(bf16_t, WS_WBS), *WBF = WSP(bf16_t, WS_WBF), *WOT = WSP(bf16_t, WS_WOT), *WPGT = WSP(bf16_t, WS_WPGT), *WPLT = WSP(bf16_t, WS_WPLT);
                LAS float* scr = (LAS float*)(lds + wave * 16384);
                constexpr int I_IN = 32 * 320, I_B = 16 * 64, I_O = 32 * 64, I_PL = 4 * 64;
                constexpr int NITEMS = I_IN + 2 * I_B + 2 * I_O + I_PL;
                for (int itn = gw; itn < NITEMS; itn += NGW) {
                    int r = itn;
                    if (r < I_IN) { const int kb = r / 320, nb = r % 320, n0 = 32 * nb; transpose_item(w_in, INC, n0 + (n0 >= 6144 ? 8 : 0), 64 * kb, g_mix, W1T, DM, n0, scr, lane); continue; } r -= I_IN;
                    if (r < I_B) { const int kb = r / 64, nb = r % 64; transpose_item(w_bsb, DM, 32 * nb, 64 * kb, nullptr, WBS, 2048, 32 * nb, scr, lane); continue; } r -= I_B;
                    if (r < I_B) { const int kb = r / 64, nb = r % 64; transpose_item(w_bfx, DM, 32 * nb, 64 * kb, nullptr, WBS + 1024, 2048, 32 * nb, scr, lane); continue; } r -= I_B;
                    if (r < I_O) { const int kb = r / 64, nb = r % 64; transpose_item(w_out, DM, 32 * nb, 64 * kb, nullptr, WOT, DM, 32 * nb, scr, lane); continue; } r -= I_O;
                    if (r < I_O) { const int kb = r / 64, nb = r % 64; transpose_item(w_pg, DM, 32 * nb, 64 * kb, g_ple, WPGT, DM, 32 * nb, scr, lane); continue; } r -= I_O;
                    { const int kb = r / 64, nb = r % 64; transpose_item(w_ple, DM, 32 * nb, 64 * kb, nullptr, WPLT, PLE, 32 * nb, scr, lane); }
                }
            }
            {
                const float* g_ffn = INP(8, DM); const float* sub_keys = INP(10, (size_t)16 * 128 * 128);
                bf16_t* SKP = WSP(bf16_t, WS_SKP);
                const size_t gt = (size_t)bid * NTHREADS + tid, ngt = (size_t)G * NTHREADS;
                convert_flat(INP(9, (size_t)DM * DM), WSP(bf16_t, WS_WQB), (size_t)DM * DM / 8, nullptr, gt, ngt);
                { const float* eu = INP(11, (size_t)NEXP * DM); const float* ev = INP(12, (size_t)NEXP * DM);
#if PEER_FP4
                  for (int rr = gw; rr < 2 * NEXP; rr += NGW) { if (rr < NEXP) quant_row_fp4(eu, g_ffn, WSP(unsigned char, WS_EU), WSP(float, WS_SU), rr, lane); else quant_row_fp4(ev, nullptr, WSP(unsigned char, WS_EV), WSP(float, WS_SV), rr - NEXP, lane); } }
#else
                  LAS float* stage = (LAS float*)(lds + wave * 16384); LAS int* pos = (LAS int*)(lds + wave * 16384 + 8704); fp6_probe(pos, pos);
                  for (int rr = gw; rr < 2 * NEXP; rr += NGW) { if (rr < NEXP) quant_row_fp6(eu, g_ffn, WSP(unsigned char, WS_EU), WSP(float, WS_SU), rr, lane, stage, pos); else quant_row_fp6(ev, nullptr, WSP(unsigned char, WS_EV), WSP(float, WS_SV), rr - NEXP, lane, stage, pos); } }
#endif
                convert_flat(INP(1, (size_t)M * PLE), WSP(bf16_t, WS_PB), (size_t)M * PLE / 8, nullptr, gt, ngt);
                for (size_t i = gt; i < (size_t)M; i += ngt) WSP(float, WS_RS)[i] = 0.f;
                for (size_t i = gt; i < (size_t)2048 * 256 / 8; i += ngt) {
                    const int n = (int)(i >> 5), c8 = (int)(i & 31) * 8, pp = (n >> 7) & 1;
                    u32x4 o = {0u, 0u, 0u, 0u};
                    if ((c8 >> 7) == pp) { const float* sp = sub_keys + (size_t)n * 128 + (c8 & 127); o = pack8(*(const f32x4*)sp, *(const f32x4*)(sp + 4)); }
                    *(u32x4*)(SKP + (size_t)n * 256 + c8) = o;
                }
            }
            __syncthreads();
            {
                const float* h_in = (L == 0) ? args.in[0] : WSP(const float, WS_H);
                const float* b_f = INP(4, NH);
                bf16_t* XN = WSP(bf16_t, WS_XN); float* LF = WSP(float, WS_LF);
                LAS float* WF = (LAS float*)lds;
                for (int i = tid; i < 8 * DM; i += NTHREADS) { const int k = i >> 3, j = i & 7; WF[j * DM + k] = w_in[(size_t)k * INC + 6144 + j] * g_mix[k]; }
                __syncthreads();
                for (int m = gw; m < M; m += NGW) {
                    const float* hr = h_in + (size_t)m * DM + 4 * lane;
                    f32x4 v[8]; float ss = 0.f;
#pragma unroll
                    for (int j = 0; j < 8; ++j) { v[j] = *(const f32x4*)(hr + 256 * j); ss += (v[j][0] * v[j][0] + v[j][1] * v[j][1]) + (v[j][2] * v[j][2] + v[j][3] * v[j][3]); }
                    const float rstd = __builtin_amdgcn_rsqf(wave_sum(ss) * (1.f / DM) + EPS);
                    u32x2* xo = (u32x2*)(XN + (size_t)m * DM) + lane;
#pragma unroll
                    for (int j = 0; j < 8; ++j) { v[j] = v[j] * rstd; u32x2 w; w.x = cvt_pk_bf16(v[j][0], v[j][1]); w.y = cvt_pk_bf16(v[j][2], v[j][3]); xo[64 * j] = w; }
                    float myf = 0.f;
#pragma unroll
                    for (int hh = 0; hh < 8; ++hh) {
                        float d = 0.f;
#pragma unroll
                        for (int j = 0; j < 8; ++j) { const f32x4 w = *(const LAS f32x4*)(WF + hh * DM + 256 * j + 4 * lane); d += (v[j][0] * w[0] + v[j][1] * w[1]) + (v[j][2] * w[2] + v[j][3] * w[3]); }
                        d = wave_sum(d);
                        myf = (lane == hh) ? d : myf;
                    }
                    if (lane < 8) {
                        const float xx = myf + b_f[lane];
                        const float ls = fminf(xx, 0.f) - log1pf(__expf(-fabsf(xx)));
                        LF[(size_t)((m >> 12) * 8 + lane) * SEQ + (m & 4095)] = ls * LOG2E;
                    }
                }
            }
            __syncthreads();
          }
            SEAM(P + 0);
        }

        if (PH_EN(1) && RUN(P + 1)) {
#ifndef REP_P1
#define REP_P1 1
#endif
          for (int rep = 0; rep < REP_P1; ++rep) {
            { PH_BEGIN
              pg8::SchedSimple S; S.t.init(M / 256, 10240 / 256, G, bid); S.A = (const char*)WSP(bf16_t, WS_XN); S.B = (const char*)WSP(bf16_t, WS_W1T); S.astride = (size_t)256 * DM * 2; S.bstride = (size_t)256 * DM * 2;
              pg8::Epi1 E{WSP(bf16_t, WS_QS), WSP(bf16_t, WS_KS), WSP(bf16_t, WS_QF), WSP(bf16_t, WS_KF), WSP(bf16_t, WS_VTS), WSP(bf16_t, WS_VTF), WSP(bf16_t, WS_G)};
              pg8::gemm_phase(lds, DM, DM, DM, S, E); }
            { PH_BEGIN
              pg8::SchedWeff S; S.t.init(8, 8, G, bid); S.A = (const char*)WSP(bf16_t, WS_SKP); S.B = (const char*)WSP(bf16_t, WS_WQB); S.astride = (size_t)256 * 256 * 2; S.bstride = (size_t)256 * DM * 2;
              pg8::EpiWeff E{WSP(bf16_t, WS_WEFF), INP(8, DM)};
              pg8::gemm_phase(lds, 256, DM, 256, S, E); }
            { PH_BEGIN
              pg8::SchedSimple S; S.t.init(M / 256, 8, G, bid); S.A = (const char*)WSP(bf16_t, WS_PB); S.B = (const char*)WSP(bf16_t, WS_WPLT); S.astride = (size_t)256 * PLE * 2; S.bstride = (size_t)256 * PLE * 2;
              pg8::EpiBf16Plain E{WSP(bf16_t, WS_PE), DM};
              pg8::gemm_phase(lds, PLE, PLE, PLE, S, E); }
          }
            SEAM(P + 1);
        }

        if (PH_EN(2) && RUN(P + 2)) {
#ifndef REP_ATT
#define REP_ATT 1
#endif
          for (int rep = 0; rep < REP_ATT; ++rep) {
            { PH_BEGIN
              bf16_t *QF = WSP(bf16_t, WS_QF), *KF = WSP(bf16_t, WS_KF), *VTF = WSP(bf16_t, WS_VTF), *OF = WSP(bf16_t, WS_OS) + 1024; const float* LF = WSP(const float, WS_LF);
              for (int w = bid; w < 256; w += G) {
                  const int bh = w >> 3, j = w & 7;
                  att::item<true>(lds, QF, KF, VTF, OF, LF, bh >> 3, bh & 7, 15 - j);
                  att::item<true>(lds, QF, KF, VTF, OF, LF, bh >> 3, bh & 7, j);
              } }
            { PH_BEGIN
              bf16_t *QS = WSP(bf16_t, WS_QS), *KS = WSP(bf16_t, WS_KS), *VTS = WSP(bf16_t, WS_VTS), *OS = WSP(bf16_t, WS_OS);
              for (int w = bid; w < 512; w += G) {
                  const int bh = w >> 4, qb = w & 15;
                  att::item<false>(lds, QS, KS, VTS, OS, nullptr, bh >> 3, bh & 7, qb);
              } }
          }
            SEAM(P + 2);
        }

        if (PH_EN(3) && RUN(P + 3)) {
#ifndef REP_P3
#define REP_P3 1
#endif
          for (int rep = 0; rep < REP_P3; ++rep) {
            PH_BEGIN
            pg8::SchedSimple S; S.t.init(M / 256, 8, G, bid); S.A = (const char*)WSP(bf16_t, WS_OS); S.B = (const char*)WSP(bf16_t, WS_WBS); S.astride = (size_t)256 * DM * 2; S.bstride = (size_t)256 * DM * 2;
            pg8::Epi2 E{WSP(bf16_t, WS_G), WSP(bf16_t, WS_XN)};
            pg8::gemm_phase<pg8::Epi2, pg8::SchedSimple, true>(lds, DM, DM, DM, S, E);
          }
            SEAM(P + 3);
        }

        if (PH_EN(4) && RUN(P + 4)) {
            PH_BEGIN
            pg8::SchedSimple S; S.t.init(M / 256, 8, G, bid); S.A = (const char*)WSP(bf16_t, WS_XN); S.B = (const char*)WSP(bf16_t, WS_WOT); S.astride = (size_t)256 * DM * 2; S.bstride = (size_t)256 * DM * 2;
            pg8::Epi3 E{(L == 0) ? args.in[0] : WSP(const float, WS_H), WSP(float, WS_H), WSP(bf16_t, WS_QS)  , WSP(float, WS_RS)};
            pg8::gemm_phase(lds, DM, DM, DM, S, E);
            SEAM(P + 4);
        }


        if (PH_EN(6) && RUN(P + 6)) {
#ifndef REP_P6
#define REP_P6 1
#endif
          for (int rep = 0; rep < REP_P6; ++rep) {
            PH_BEGIN
            pg8::SchedSimple S; S.t.init(M / 256, 8, G, bid); S.A = (const char*)WSP(bf16_t, WS_QS); S.B = (const char*)WSP(bf16_t, WS_WEFF); S.astride = (size_t)256 * DM * 2; S.bstride = (size_t)256 * DM * 2;
            pg8::EpiF32 E{WSP(float, WS_T1), WSP(const float, WS_RS)};
            pg8::gemm_phase(lds, DM, DM, DM, S, E);
          }
            SEAM(P + 6);
        }

        if (PH_EN(7) && RUN(P + 7)) {
            PH_BEGIN
            LAS unsigned char* wl = lds + wave * 2048;
            const float* T1 = WSP(const float, WS_T1); bf16_t* XN = WSP(bf16_t, WS_XN); const bf16_t* XIN = WSP(const bf16_t, WS_QS); float* HB = WSP(float, WS_H); const unsigned char *EU = WSP(const unsigned char, WS_EU), *EV = WSP(const unsigned char, WS_EV); const float *SU = WSP(const float, WS_SU), *SV = WSP(const float, WS_SV), *RS = WSP(const float, WS_RS);
#ifdef REP_PEER
            for (int m = gw; m < M; m += NGW) peer::token(wl, T1, XIN, XN, HB, EU, EV, SU, SV, RS, m, lane, true);
#endif
            for (int m = gw; m < M; m += NGW) peer::token(wl, T1, XIN, XN, HB, EU, EV, SU, SV, RS, m, lane);
            SEAM(P + 7);
        }

        if (PH_EN(8) && RUN(P + 8)) {
            PH_BEGIN
            pg8::SchedSimple S; S.t.init(M / 256, 8, G, bid); S.A = (const char*)WSP(bf16_t, WS_XN); S.B = (const char*)WSP(bf16_t, WS_WPGT); S.astride = (size_t)256 * DM * 2; S.bstride = (size_t)256 * DM * 2;
            pg8::Epi10 E{WSP(float, WS_H), WSP(const bf16_t, WS_PE)};
            pg8::gemm_phase(lds, DM, DM, DM, S, E);
            SEAM(P + 8);
        }
    }
    if (PH_EN(9) && RUN(DEPTH * 9)) {
        const int Lc = 0;
        PH_BEGIN
        const float* gfin = args.in[16]; const float* HB = WSP(const float, WS_H);
        for (int m = gw; m < M; m += NGW) {
            const float* hr = HB + (size_t)m * DM + 4 * lane;
            f32x4 v[8]; float ss = 0.f;
#pragma unroll
            for (int j = 0; j < 8; ++j) { v[j] = *(const f32x4*)(hr + 256 * j); ss += (v[j][0] * v[j][0] + v[j][1] * v[j][1]) + (v[j][2] * v[j][2] + v[j][3] * v[j][3]); }
            const float rstd = __builtin_amdgcn_rsqf(wave_sum(ss) * (1.f / DM) + EPS);
            float* op = args.out + (size_t)m * DM + 4 * lane;
#pragma unroll
            for (int j = 0; j < 8; ++j) { const f32x4 gg = *(const f32x4*)(gfin + 256 * j + 4 * lane); *(f32x4*)(op + 256 * j) = v[j] * rstd * gg; }
        }
    }
#undef RUN
#undef SEAM
}

extern "C" void kernel_launch(void* const* d_in, const int* in_sizes, int n_in, void* d_out, int out_size, void* d_ws, size_t ws_size, hipStream_t stream) {
    static int grid = 0;
    if (grid == 0) {
        if (n_in != 17 || out_size != M * DM || ws_size < WS_END) { fprintf(stderr, "kernel_launch: unexpected problem (n_in %d, out %d, ws %zu)\n", n_in, out_size, ws_size); grid = -1; return; }
        int dev = 0, cus = 0, per_cu = 0;
        hipGetDevice(&dev); hipDeviceGetAttribute(&cus, hipDeviceAttributeMultiprocessorCount, dev);
        if (hipFuncSetAttribute((const void*)fwd_kernel, hipFuncAttributeMaxDynamicSharedMemorySize, LDS_BYTES) != hipSuccess) { fprintf(stderr, "kernel_launch: hipFuncSetAttribute failed\n"); grid = -1; return; }
        if (hipOccupancyMaxActiveBlocksPerMultiprocessor(&per_cu, (const void*)fwd_kernel, NTHREADS, LDS_BYTES) != hipSuccess || per_cu < 1) { fprintf(stderr, "kernel_launch: occupancy query says %d blocks per CU\n", per_cu); per_cu = 1; }
        (void)hipGetLastError();
        grid = cus * per_cu;
        fprintf(stderr, "kernel_launch: grid %d (cus %d x %d)\n", grid, cus, per_cu);
    }
    if (grid < 0) return;
    Args a{};
    for (int i = 0; i < 17; ++i) a.in[i] = (const float*)d_in[i];
    a.out = (float*)d_out; a.ws = (unsigned char*)d_ws;
    constexpr int NPH = DEPTH * 9 + 1;
    if (hipMemsetAsync((char*)d_ws + WS_CTL, 0, CTL_BYTES, stream) != hipSuccess) { fprintf(stderr, "kernel_launch: memset of the barrier words failed\n"); return; }
#if MK_SPLIT
    for (int p = 0; p < NPH; ++p) { a.ph_lo = p; a.ph_hi = p + 1; hipLaunchKernelGGL(fwd_kernel, dim3(grid), dim3(NTHREADS), LDS_BYTES, stream, a); }
#else
    a.ph_lo = 0; a.ph_hi = NPH;
    void* kargs[] = {&a};
    hipError_t e = hipLaunchCooperativeKernel((const void*)fwd_kernel, dim3(grid), dim3(NTHREADS), kargs, LDS_BYTES, stream);
    if (e != hipSuccess) fprintf(stderr, "kernel_launch: cooperative launch failed: %s (grid %d)\n", hipGetErrorString(e), grid);
#endif
}
```

```cpp
#include <hip/hip_runtime.h>
#include <hip/hip_cooperative_groups.h>
#include <cstdio>
#include <cstdint>
namespace cg = cooperative_groups;

#ifndef MK_SPLIT
#define MK_SPLIT 0
#endif

#define LAS __attribute__((address_space(3)))
typedef unsigned short bf16_t;
typedef short bf16x8 __attribute__((ext_vector_type(8)));
typedef float f32x4 __attribute__((ext_vector_type(4)));
typedef float f32x16 __attribute__((ext_vector_type(16)));
typedef unsigned u32x4 __attribute__((ext_vector_type(4)));
typedef unsigned u32x2 __attribute__((ext_vector_type(2)));
typedef __bf16 bf16v2 __attribute__((ext_vector_type(2)));
typedef float f32x2 __attribute__((ext_vector_type(2)));
typedef float v16f __attribute__((ext_vector_type(16)));
typedef float v32f __attribute__((ext_vector_type(32)));
typedef unsigned v6u __attribute__((ext_vector_type(6)));
#ifndef PEER_FP4
#define PEER_FP4 1
#endif
constexpr int ROWB = PEER_FP4 ? 1024 : 1536;

constexpr int M = 16384, DM = 2048, SEQ = 4096, NB = 4, NH = 8, HD = 128, DEPTH = 2;
constexpr int INC = 10248;
constexpr int PLE = 256;
constexpr int NEXP = 16384;
constexpr float LOG2E = 1.4426950408889634f;
constexpr float QSCALE = 0.08838834764831845f * 1.4426950408889634f;
constexpr float EPS = 1e-6f;
constexpr int NWAVES = 8, NTHREADS = 512;
constexpr int LDS_BYTES = 147456;

__device__ __forceinline__ unsigned cvt_pk_bf16(float lo, float hi) { unsigned r; asm volatile("v_cvt_pk_bf16_f32 %0, %1, %2" : "=v"(r) : "v"(lo), "v"(hi)); return r; }
__device__ __forceinline__ u32x4 pack8(f32x4 a, f32x4 b) { u32x4 w; w.x = cvt_pk_bf16(a[0], a[1]); w.y = cvt_pk_bf16(a[2], a[3]); w.z = cvt_pk_bf16(b[0], b[1]); w.w = cvt_pk_bf16(b[2], b[3]); return w; }
__device__ __forceinline__ float bflo(unsigned w) { return __builtin_bit_cast(float, w << 16); }
__device__ __forceinline__ float bfhi(unsigned w) { return __builtin_bit_cast(float, w & 0xffff0000u); }
__device__ __forceinline__ float sigmoidf_(float x) { return __builtin_amdgcn_rcpf(1.f + __builtin_amdgcn_exp2f(-x * LOG2E)); }
__device__ __forceinline__ float wave_sum(float v) {
#pragma unroll
    for (int o = 1; o < 64; o <<= 1) v += __shfl_xor(v, o);
    return v;
}

namespace pg8 {
constexpr int BM = 256, BK = 64, HALF = 128, HTB = HALF * BK * 2, STAGE_BYTES = 8 * HTB, NXCD = 8, WGM = 8;
__host__ __device__ __forceinline__ int lds_byte(int r, int c) { const int st = (r >> 4) * 2 + (c >> 5), rr = r & 15, cc = c & 31, ob = rr * 64 + cc * 2; return st * 1024 + (ob ^ (((ob >> 9) & 1) << 5)); }
__host__ __device__ __forceinline__ void stage_rc(int b, int& R, int& C) { const int st = b / 1024, sb = b % 1024, swz = sb ^ (((sb >> 9) & 1) << 5); R = (st >> 1) * 16 + swz / 64; C = (st & 1) * 32 + (swz % 64) / 2; }
__host__ __device__ __forceinline__ int perm32(int rho) { const int n = rho >> 4, i = rho & 15; return 8 * (i >> 2) + 4 * n + (i & 3); }

struct Unit { int pm, pn, aux; const char* a; const char* b; };
struct Tiles {
    int nM, nN, nwg, G, c;
    __device__ void init(int nM_, int nN_, int G_, int c_) { nM = nM_; nN = nN_; nwg = nM * nN; G = G_; c = c_; }
    __device__ bool tile(int i, int& pm, int& pn) const {
        const long L = (long)i * G + c; if (L >= nwg) return false;
        int wgid = (int)L; { const int q = nwg / NXCD, r = nwg % NXCD, xcd = wgid % NXCD, off = wgid / NXCD; wgid = (xcd < r ? xcd * (q + 1) : r * (q + 1) + (xcd - r) * q) + off; }
        const int nig = WGM * nN, gid = wgid / nig, fm = gid * WGM, gsz = (nM - fm) < WGM ? (nM - fm) : WGM;
        pm = fm + ((wgid % nig) % gsz); pn = (wgid % nig) / gsz; return true;
    }
};

template <class Epi, class Sched, bool HAS_MID = false>
__device__ __forceinline__ void gemm_phase(LAS unsigned char* lds, const int lda, const int ldb, const int K, const Sched& S, const Epi& E) {
    int tid = threadIdx.x; asm volatile("" : "+v"(tid));
    const int wid = __builtin_amdgcn_readfirstlane(tid >> 6), lane = tid & 63, wr = wid >> 2, wc = wid & 3, fr = lane & 15, fq = lane >> 4;
    int Kv = K; asm volatile("" : "+s"(Kv));
    const int nt = Kv / BK;
    unsigned voffA[2], voffB[2];
#pragma unroll
    for (int i = 0; i < 2; ++i) { int R, C; stage_rc(tid * 16 + i * 8192, R, C); const int Rb = (R & ~31) + perm32(R & 31);
        voffA[i] = (unsigned)(R * lda + C) * 2u; voffB[i] = (unsigned)(Rb * ldb + C) * 2u; }
    const size_t kstep = (size_t)(BK * 2);
    const size_t hstepA = (size_t)HALF * lda * 2, hstepB = (size_t)HALF * ldb * 2;
    const unsigned ldsw = (unsigned)wid * 1024u;
    const int aoff = lds_byte(wr * 64 + fr, fq * 8), boff = lds_byte(wc * 32 + fr, fq * 8);
#define PG8_SA(b, h) (((b) * 2 + (h)) * HTB)
#define PG8_SB(b, h) ((4 + (b) * 2 + (h)) * HTB)
#define PG8_STAGE(bufoff, gbase, voff) do { _Pragma("unroll") for (int _i = 0; _i < 2; ++_i) \
        __builtin_amdgcn_global_load_lds((const unsigned*)((const char*)(gbase) + (voff)[_i]), (LAS unsigned*)(lds + (bufoff) + ldsw + _i * 8192), 16, 0, 0); } while (0)
#define PG8_LDA(dst, b, h) do { _Pragma("unroll") for (int m = 0; m < 4; ++m) _Pragma("unroll") for (int k = 0; k < 2; ++k) dst[m][k] = *(const LAS bf16x8*)(lds + PG8_SA(b, h) + aoff + m * 2048 + k * 1024); } while (0)
#define PG8_LDB(dst, b, h) do { _Pragma("unroll") for (int n = 0; n < 2; ++n) _Pragma("unroll") for (int k = 0; k < 2; ++k) dst[n][k] = *(const LAS bf16x8*)(lds + PG8_SB(b, h) + boff + n * 2048 + k * 1024); } while (0)
#define PG8_MMA(ai, bj, At, Bt) do { __builtin_amdgcn_s_setprio(1); _Pragma("unroll") for (int m = 0; m < 4; ++m) _Pragma("unroll") for (int n = 0; n < 2; ++n) _Pragma("unroll") for (int k = 0; k < 2; ++k) \
        acc[ai][bj][m][n] = __builtin_amdgcn_mfma_f32_16x16x32_bf16(Bt[n][k], At[m][k], acc[ai][bj][m][n], 0, 0, 0); __builtin_amdgcn_s_setprio(0); } while (0)
#define PG8_WAIT_V(n) asm volatile("s_waitcnt vmcnt(" #n ")" ::: "memory")
#define PG8_WAIT_L(n) asm volatile("s_waitcnt lgkmcnt(" #n ")" ::: "memory")
#define PG8_BAR __builtin_amdgcn_s_barrier()
#define PG8_SCHED __builtin_amdgcn_sched_barrier(0)
    Unit cur, nxt; int ui = 0;
    if (!S.next(0, cur)) return;
    f32x4 acc[2][2][4][2];
#pragma unroll
    for (int a = 0; a < 2; ++a)
#pragma unroll
        for (int b = 0; b < 2; ++b)
#pragma unroll
            for (int m = 0; m < 4; ++m)
#pragma unroll
                for (int n = 0; n < 2; ++n) acc[a][b][m][n] = (f32x4){0.f, 0.f, 0.f, 0.f};
    bf16x8 At[4][2], B0[2][2], B1[2][2];
    const char* cA = cur.a; const char* cB = cur.b;
    PG8_STAGE(PG8_SB(0, 0), cB, voffB); PG8_STAGE(PG8_SB(0, 1), cB + hstepB, voffB); PG8_STAGE(PG8_SA(0, 0), cA, voffA); PG8_STAGE(PG8_SA(0, 1), cA + hstepA, voffA);
    if (wr == 1) PG8_BAR;
    PG8_WAIT_V(2); PG8_BAR;
    PG8_STAGE(PG8_SB(1, 0), cB + kstep, voffB); PG8_STAGE(PG8_SA(1, 0), cA + kstep, voffA); PG8_STAGE(PG8_SB(1, 1), cB + hstepB + kstep, voffB);
    PG8_WAIT_V(6); PG8_BAR;
    for (;;) {
        const bool has_next = S.next(ui + 1, nxt);
        const char* nA = has_next ? nxt.a : cA; const char* nB = has_next ? nxt.b : cB;
        for (int t = 0; t < nt; t += 2) {
            const bool last = (t == nt - 2);
            if constexpr (HAS_MID) { if (t == (nt >> 1)) E.mid(acc, cur, wr, wc, fr, fq); }
            const char* a1 = cA + (size_t)(t + 1) * kstep;
            const char* a2 = last ? nA : cA + (size_t)(t + 2) * kstep; const char* b2 = last ? nB : cB + (size_t)(t + 2) * kstep;
            const char* a3 = a2 + kstep; const char* b3 = b2 + kstep;
            PG8_LDB(B0, 0, 0); PG8_LDB(B1, 0, 1); PG8_SCHED; PG8_LDA(At, 0, 0); PG8_STAGE(PG8_SA(1, 1), a1 + hstepA, voffA);
            PG8_WAIT_V(8); PG8_WAIT_L(0); PG8_BAR; PG8_MMA(0, 0, At, B0); PG8_MMA(0, 1, At, B1); PG8_BAR; PG8_SCHED;
            PG8_LDA(At, 0, 1); PG8_STAGE(PG8_SB(0, 0), b2, voffB); PG8_STAGE(PG8_SB(0, 1), b2 + hstepB, voffB); PG8_STAGE(PG8_SA(0, 0), a2, voffA);
            PG8_WAIT_V(8); PG8_WAIT_L(0); PG8_BAR; PG8_MMA(1, 0, At, B0); PG8_MMA(1, 1, At, B1); PG8_BAR; PG8_SCHED;
            PG8_LDB(B0, 1, 0); PG8_LDB(B1, 1, 1); PG8_SCHED; PG8_LDA(At, 1, 0); PG8_STAGE(PG8_SA(0, 1), a2 + hstepA, voffA);
            PG8_WAIT_V(8); PG8_WAIT_L(0); PG8_BAR; PG8_MMA(0, 0, At, B0); PG8_MMA(0, 1, At, B1); PG8_BAR; PG8_SCHED;
            PG8_LDA(At, 1, 1); PG8_STAGE(PG8_SB(1, 0), b3, voffB); PG8_STAGE(PG8_SB(1, 1), b3 + hstepB, voffB); PG8_STAGE(PG8_SA(1, 0), a3, voffA);
            PG8_WAIT_V(8); PG8_WAIT_L(0); PG8_BAR; PG8_MMA(1, 0, At, B0); PG8_MMA(1, 1, At, B1); PG8_BAR; PG8_SCHED;
        }
        if (wr == 0) PG8_BAR;
        E(acc, cur, wr, wc, fr, fq);
        if (!has_next) break;
#pragma unroll
        for (int a = 0; a < 2; ++a)
#pragma unroll
            for (int b = 0; b < 2; ++b)
#pragma unroll
                for (int m = 0; m < 4; ++m)
#pragma unroll
                    for (int n = 0; n < 2; ++n) acc[a][b][m][n] = (f32x4){0.f, 0.f, 0.f, 0.f};
        cur = nxt; cA = nA; cB = nB; ++ui;
        if (wr == 1) PG8_BAR;
    }
    PG8_WAIT_V(0);
    PG8_BAR;
#undef PG8_SA
#undef PG8_SB
#undef PG8_STAGE
#undef PG8_LDA
#undef PG8_LDB
#undef PG8_MMA
#undef PG8_WAIT_V
#undef PG8_WAIT_L
#undef PG8_BAR
#undef PG8_SCHED
}

struct SchedSimple {
    Tiles t; const char* A; const char* B; size_t astride, bstride;
    __device__ bool next(int i, Unit& u) const { if (!t.tile(i, u.pm, u.pn)) return false; u.aux = 0; u.a = A + (size_t)u.pm * astride; u.b = B + (size_t)u.pn * bstride; return true; }
};
struct SchedTwoPass {
    Tiles t; const char* A0; const char* A1; const char* B0; const char* B1; size_t astride, bstride;
    __device__ bool next(int i, Unit& u) const { if (!t.tile(i >> 1, u.pm, u.pn)) return false; u.aux = i & 1;
        u.a = (u.aux ? A1 : A0) + (size_t)u.pm * astride; u.b = (u.aux ? B1 : B0) + (size_t)u.pn * bstride; return true; }
};
struct SchedWeff {
    Tiles t; const char* A; const char* B; size_t astride, bstride;
    __device__ bool next(int i, Unit& u) const { if (!t.tile(i, u.pm, u.pn)) return false; u.aux = 0; u.a = A + (size_t)u.pm * astride; u.b = B + (size_t)u.pn * bstride + (size_t)u.pm * 512; return true; }
};

#define EPI_BEGIN { const int row0 = u.pm * 256 + wr * 64 + fr, col0 = u.pn * 256 + wc * 32 + 8 * fq; \
    _Pragma("unroll") for (int ai = 0; ai < 2; ++ai) _Pragma("unroll") for (int m = 0; m < 4; ++m) _Pragma("unroll") for (int bj = 0; bj < 2; ++bj) { \
        int row = row0 + ai * 128 + m * 16; const int col = col0 + bj * 128; asm volatile("" : "+v"(row)); f32x4 v0 = acc[ai][bj][m][0], v1 = acc[ai][bj][m][1];
#define EPI_END } }
typedef const f32x4 (&AccRef)[2][2][4][2];
typedef f32x4 (&AccMut)[2][2][4][2];

struct Epi1 {
    bf16_t *QS, *KS, *QF, *KF, *VTS, *VTF, *G;
    __device__ __forceinline__ void operator()(AccRef acc, const Unit& u, int wr, int wc, int fr, int fq) const {
        const int pn = u.pn;
        if (pn >= 24) {
            EPI_BEGIN { f32x4 a, b;
#pragma unroll
                for (int e = 0; e < 4; ++e) { a[e] = sigmoidf_(v0[e]); b[e] = sigmoidf_(v1[e]); }
                *(u32x4*)(G + (size_t)row * 4096 + (col - 6144)) = pack8(a, b); } EPI_END
        } else {
            const int t = pn >> 2;
            if (t == 2 || t == 5) {
                bf16_t* VT = (t == 2) ? VTS : VTF;
                EPI_BEGIN { const int c = col - t * 1024; const int hh = c >> 7, d = c & 127; const int b = row >> 12, s = row & 4095;
                    bf16_t* p = VT + ((size_t)((b * 8 + hh) * 128 + d)) * SEQ + s; const u32x4 w = pack8(v0, v1);
                    p[0] = (bf16_t)(w.x & 0xffff); p[SEQ] = (bf16_t)(w.x >> 16); p[2 * SEQ] = (bf16_t)(w.y & 0xffff); p[3 * SEQ] = (bf16_t)(w.y >> 16);
                    p[4 * SEQ] = (bf16_t)(w.z & 0xffff); p[5 * SEQ] = (bf16_t)(w.z >> 16); p[6 * SEQ] = (bf16_t)(w.w & 0xffff); p[7 * SEQ] = (bf16_t)(w.w >> 16); } EPI_END
            } else {
                bf16_t* dst = (t == 0) ? QS : (t == 1) ? KS : (t == 3) ? QF : KF; const float sc = (t == 0 || t == 3) ? QSCALE : 1.f;
                EPI_BEGIN { *(u32x4*)(dst + (size_t)row * 1024 + (col - t * 1024)) = pack8(v0 * sc, v1 * sc); } EPI_END
            }
        }
    }
};
struct EpiBf16Plain { bf16_t* O; int ldc;
    __device__ __forceinline__ void operator()(AccRef acc, const Unit& u, int wr, int wc, int fr, int fq) const {
        EPI_BEGIN { *(u32x4*)(O + (size_t)row * ldc + col) = pack8(v0, v1); } EPI_END } };
struct EpiWeff { bf16_t* O; const float* gain;
    __device__ __forceinline__ void operator()(AccRef acc, const Unit& u, int wr, int wc, int fr, int fq) const {
        EPI_BEGIN { const f32x4 g0 = *(const f32x4*)(gain + col), g1 = *(const f32x4*)(gain + col + 4); *(u32x4*)(O + (size_t)row * DM + col) = pack8(v0 * g0, v1 * g1); } EPI_END } };
struct Epi2 { const bf16_t* G; bf16_t* MG;
    __device__ __forceinline__ void mid(AccMut acc, const Unit& u, int wr, int wc, int fr, int fq) const {
        const int row0 = u.pm * 256 + wr * 64 + fr, col0 = u.pn * 256 + wc * 32 + 8 * fq;
#pragma unroll
        for (int ai = 0; ai < 2; ++ai)
#pragma unroll
            for (int m = 0; m < 4; ++m)
#pragma unroll
                for (int bj = 0; bj < 2; ++bj) {
                    int row = row0 + ai * 128 + m * 16; const int col = col0 + bj * 128; asm volatile("" : "+v"(row));
                    const bf16_t* gp = G + (size_t)row * 4096 + col;
                    const u32x4 g1 = *(const u32x4*)gp, g2 = *(const u32x4*)(gp + 2048);
                    f32x4 ra, rb;
#pragma unroll
                    for (int t = 0; t < 2; ++t) {
                        ra[2 * t] = bflo(g1[t]) * __builtin_amdgcn_rcpf(fmaxf(bflo(g2[t]), 1e-30f)); ra[2 * t + 1] = bfhi(g1[t]) * __builtin_amdgcn_rcpf(fmaxf(bfhi(g2[t]), 1e-30f));
                        rb[2 * t] = bflo(g1[2 + t]) * __builtin_amdgcn_rcpf(fmaxf(bflo(g2[2 + t]), 1e-30f)); rb[2 * t + 1] = bfhi(g1[2 + t]) * __builtin_amdgcn_rcpf(fmaxf(bfhi(g2[2 + t]), 1e-30f));
                    }
                    acc[ai][bj][m][0] = acc[ai][bj][m][0] * ra; acc[ai][bj][m][1] = acc[ai][bj][m][1] * rb;
                }
    }
    __device__ __forceinline__ void operator()(AccRef acc, const Unit& u, int wr, int wc, int fr, int fq) const {
        EPI_BEGIN { const u32x4 gv = *(const u32x4*)(G + (size_t)row * 4096 + 2048 + col);
            f32x4 a = {fmaxf(bflo(gv.x), 1e-30f), fmaxf(bfhi(gv.x), 1e-30f), fmaxf(bflo(gv.y), 1e-30f), fmaxf(bfhi(gv.y), 1e-30f)}, b = {fmaxf(bflo(gv.z), 1e-30f), fmaxf(bfhi(gv.z), 1e-30f), fmaxf(bflo(gv.w), 1e-30f), fmaxf(bfhi(gv.w), 1e-30f)};
            *(u32x4*)(MG + (size_t)row * DM + col) = pack8(v0 * a, v1 * b); } EPI_END
    } };
struct Epi3 { const float* HIN; float* HOUT; bf16_t* XB; float* RS;
    __device__ __forceinline__ void operator()(AccRef acc, const Unit& u, int wr, int wc, int fr, int fq) const {
        const int row0 = u.pm * 256 + wr * 64 + fr, col0 = u.pn * 256 + wc * 32 + 8 * fq;
#pragma unroll
        for (int ai = 0; ai < 2; ++ai)
#pragma unroll
            for (int m = 0; m < 4; ++m) {
                int row = row0 + ai * 128 + m * 16; asm volatile("" : "+v"(row));
                float ssq = 0.f;
#pragma unroll
                for (int bj = 0; bj < 2; ++bj) {
                    const int col = col0 + bj * 128;
                    const float* ip = HIN + (size_t)row * DM + col; float* op = HOUT + (size_t)row * DM + col;
                    const f32x4 h0 = *(const f32x4*)ip + acc[ai][bj][m][0], h1 = *(const f32x4*)(ip + 4) + acc[ai][bj][m][1];
                    *(f32x4*)op = h0; *(f32x4*)(op + 4) = h1;
                    *(u32x4*)(XB + (size_t)row * DM + col) = pack8(h0, h1);
                    ssq += (h0[0] * h0[0] + h0[1] * h0[1]) + (h0[2] * h0[2] + h0[3] * h0[3]) + (h1[0] * h1[0] + h1[1] * h1[1]) + (h1[2] * h1[2] + h1[3] * h1[3]);
                }
                ssq += __shfl_xor(ssq, 16); ssq += __shfl_xor(ssq, 32);
                if (fq == 0) (void)__hip_atomic_fetch_add(RS + row, ssq, __ATOMIC_RELAXED, __HIP_MEMORY_SCOPE_AGENT);
            }
    } };
struct EpiF32 { bf16_t* O; const float* RS;
    __device__ __forceinline__ void operator()(AccRef acc, const Unit& u, int wr, int wc, int fr, int fq) const {
        EPI_BEGIN { const float rstd = __builtin_amdgcn_rsqf(RS[row] * (1.f / DM) + EPS); *(u32x4*)(O + (size_t)row * DM + col) = pack8(v0 * rstd, v1 * rstd); } EPI_END } };
struct Epi10 { float* H; const bf16_t* PE;
    __device__ __forceinline__ void operator()(AccRef acc, const Unit& u, int wr, int wc, int fr, int fq) const {
        EPI_BEGIN { const u32x4 pv = *(const u32x4*)(PE + (size_t)row * DM + col);
            f32x4 a = {bflo(pv.x), bfhi(pv.x), bflo(pv.y), bfhi(pv.y)}, b = {bflo(pv.z), bfhi(pv.z), bflo(pv.w), bfhi(pv.w)};
            f32x4 s0, s1;
#pragma unroll
            for (int e = 0; e < 4; ++e) { s0[e] = sigmoidf_(v0[e]); s1[e] = sigmoidf_(v1[e]); }
            float* hp = H + (size_t)row * DM + col; const f32x4 h0 = *(const f32x4*)hp, h1 = *(const f32x4*)(hp + 4);
            *(f32x4*)hp = h0 + s0 * a; *(f32x4*)(hp + 4) = h1 + s1 * b; } EPI_END } };
}

namespace att {
constexpr int KP = 272, VP = 144, KTB = 64 * KP, VTB = 128 * VP, BUFB = KTB + VTB;
constexpr int F2_OFF = 2 * BUFB, FLAG_OFF = F2_OFF + 16384, WT_OFF = FLAG_OFF + 64;
constexpr float NEG_INF = -__builtin_inff();
constexpr float DEAD = -160.f;

#define MFMA32(a, b, c) __builtin_amdgcn_mfma_f32_32x32x16_bf16((a), (b), (c), 0, 0, 0)

template <bool FOX>
__device__ __forceinline__ void item(LAS unsigned char* lds, const bf16_t* Qp, const bf16_t* __restrict__ Kp, const bf16_t* __restrict__ VTp, bf16_t* Op,
                                     const float* __restrict__ LF, const int b, const int h, const int qb) {
    int tid = threadIdx.x; asm volatile("" : "+v"(tid));
    const int wave = __builtin_amdgcn_readfirstlane(tid >> 6), lane = tid & 63, g = lane >> 5, ql = lane & 31;
    const int q0 = qb * 256, myrow0 = q0 + wave * 32, myq = myrow0 + ql;
    const size_t tokbase = (size_t)b * SEQ;
    const bf16_t* Kg = Kp + tokbase * 1024 + h * 128;
    const bf16_t* Vg = VTp + (size_t)((b * 8 + h) * 128) * SEQ;
    const int kr = tid >> 4, kc = tid & 15, vr = tid >> 3, vc = tid & 7;
    u32x4 kreg0, kreg1, vreg0, vreg1;
#define ATT_LOAD(kt) { const bf16_t* kp_ = Kg + (size_t)((kt) * 64 + kr) * 1024 + kc * 8; kreg0 = *(const u32x4*)kp_; kreg1 = *(const u32x4*)(kp_ + 32 * 1024); \
        const bf16_t* vp_ = Vg + (size_t)vr * SEQ + (kt) * 64 + vc * 8; vreg0 = *(const u32x4*)vp_; vreg1 = *(const u32x4*)(vp_ + (size_t)64 * SEQ); }
#define ATT_STORE(buf) { LAS unsigned char* kb_ = lds + (buf) * BUFB; *(LAS u32x4*)(kb_ + kr * KP + kc * 16) = kreg0; *(LAS u32x4*)(kb_ + (kr + 32) * KP + kc * 16) = kreg1; \
        LAS unsigned char* vb_ = kb_ + KTB; *(LAS u32x4*)(vb_ + vr * VP + vc * 16) = vreg0; *(LAS u32x4*)(vb_ + (vr + 64) * VP + vc * 16) = vreg1; }
    const int kt_hi = qb * 4 + 3;
    __syncthreads();
    ATT_LOAD(kt_hi);
    bf16x8 qf[8];
    { const bf16_t* qp = Qp + (tokbase + myq) * 1024 + h * 128 + 8 * g;
#pragma unroll
      for (int kk = 0; kk < 8; ++kk) qf[kk] = *(const bf16x8*)(qp + 16 * kk); }
    LAS float* F2 = (LAS float*)(lds + F2_OFF);
    LAS int* flags = (LAS int*)(lds + FLAG_OFF);
    LAS float* WT = (LAS float*)(lds + WT_OFF);
    if (tid < 16) flags[tid] = 0;
    if (FOX) {
        const float* lf = LF + (size_t)(b * 8 + h) * SEQ + 8 * tid;
        const f32x4 a = *(const f32x4*)lf, c = *(const f32x4*)(lf + 4);
        float p[8]; p[0] = a[0]; p[1] = p[0] + a[1]; p[2] = p[1] + a[2]; p[3] = p[2] + a[3]; p[4] = p[3] + c[0]; p[5] = p[4] + c[1]; p[6] = p[5] + c[2]; p[7] = p[6] + c[3];
        float sc = p[7];
#pragma unroll
        for (int off = 1; off < 64; off <<= 1) { const float t = __shfl_up(sc, off); if (lane >= off) sc += t; }
        if (lane == 63) WT[wave] = sc;
        __syncthreads();
        float base = sc - p[7];
        for (int w = 0; w < wave; ++w) base += WT[w];
        *(LAS f32x4*)(F2 + 8 * tid) = (f32x4){base + p[0], base + p[1], base + p[2], base + p[3]};
        *(LAS f32x4*)(F2 + 8 * tid + 4) = (f32x4){base + p[4], base + p[5], base + p[6], base + p[7]};
    }
    ATT_STORE(0);
    __syncthreads();
    const int kl = 16 * (ql >> 4) + 8 * ((ql >> 2) & 1) + 4 * ((ql >> 3) & 1) + (ql & 3);
    const int koff = kl * KP + 16 * g;
    const int voff = KTB + ql * VP + 16 * g;
    f32x16 o[4];
#pragma unroll
    for (int d = 0; d < 4; ++d)
#pragma unroll
        for (int i = 0; i < 16; ++i) o[d][i] = 0.f;
    float carry = 0.f;
    float m_run = NEG_INF, l_run = 0.f;
    int it = 0;
    for (int kt = kt_hi; kt >= 0; --kt, ++it) {
        const int cur = it & 1;
        if (kt > 0) ATT_LOAD(kt - 1);
        if (!FOX && it > 0) {
            int alldead = 1;
#pragma unroll
            for (int w = 0; w < 8; ++w) alldead &= flags[((it - 1) & 1) * 8 + w];
            if (alldead) break;
        }
        LAS const unsigned char* buf = lds + cur * BUFB;
        const int k0 = kt * 64;
#pragma unroll
        for (int kb2 = 1; kb2 >= 0; --kb2) {
            const int kbase = k0 + 32 * kb2;
            const bool skip = FOX ? (kbase > myrow0 + 31) : (kbase >= myrow0 + 31);
            if (skip) continue;
            const bool need_mask = FOX ? (kbase + 31 > myrow0) : (kbase + 31 >= myrow0);
            f32x16 s;
#pragma unroll
            for (int i = 0; i < 16; ++i) s[i] = 0.f;
            { LAS const unsigned char* kb = buf + kb2 * 32 * KP + koff;
#pragma unroll
              for (int kk = 0; kk < 8; ++kk) { const bf16x8 kf = *(LAS const bf16x8*)(kb + 32 * kk); s = MFMA32(kf, qf[kk], s); } }
            const int sp0 = kbase + 8 * g;
            float pr[16];
            if (!FOX) {
                float l1m[16], lb[16];
#pragma unroll
                for (int i = 0; i < 16; ++i) {
                    const float y = s[i];
                    const float sp2 = fmaxf(y, 0.f) + __builtin_amdgcn_logf(1.f + __builtin_amdgcn_exp2f(-fabsf(y)));
                    const bool valid = !need_mask || (sp0 + 16 * (i >> 3) + (i & 7) < myq);
                    l1m[i] = valid ? -sp2 : 0.f; lb[i] = valid ? (y - sp2) : NEG_INF;
                }
                float aft[16], R0 = 0.f, R1 = 0.f;
#pragma unroll
                for (int e = 7; e >= 0; --e) { aft[e] = R0; R0 += l1m[e]; aft[8 + e] = R1; R1 += l1m[8 + e]; }
                const float P0 = __shfl_xor(R0, 32), P1 = __shfl_xor(R1, 32);
                const float off1 = carry + (g ? 0.f : P1);
                const float off0 = carry + (g ? (R1 + P1) : (P1 + R1 + P0));
#pragma unroll
                for (int i = 0; i < 16; ++i) pr[i] = __builtin_amdgcn_exp2f(lb[i] + aft[i] + (i < 8 ? off0 : off1));
                carry += (R0 + R1) + (P0 + P1);
            } else {
                float y2[16];
#pragma unroll
                for (int c = 0; c < 2; ++c) {
                    const f32x4 fa = *(LAS const f32x4*)(F2 + sp0 + 16 * c), fb = *(LAS const f32x4*)(F2 + sp0 + 16 * c + 4);
#pragma unroll
                    for (int e = 0; e < 4; ++e) { y2[8 * c + e] = s[8 * c + e] - fa[e]; y2[8 * c + 4 + e] = s[8 * c + 4 + e] - fb[e]; }
                }
                if (need_mask) {
#pragma unroll
                    for (int i = 0; i < 16; ++i) y2[i] = (sp0 + 16 * (i >> 3) + (i & 7) <= myq) ? y2[i] : NEG_INF;
                }
                float bm = y2[0];
#pragma unroll
                for (int i = 1; i < 16; ++i) bm = fmaxf(bm, y2[i]);
                bm = fmaxf(bm, __shfl_xor(bm, 32));
                const float mn = fmaxf(m_run, bm);
                const float ms = (mn == NEG_INF) ? 0.f : mn;
                const float alpha = __builtin_amdgcn_exp2f(m_run - ms);
                float rs = 0.f;
#pragma unroll
                for (int i = 0; i < 16; ++i) { pr[i] = __builtin_amdgcn_exp2f(y2[i] - ms); rs += pr[i]; }
                l_run = l_run * alpha + rs; m_run = mn;
                if (__builtin_amdgcn_ballot_w64(alpha != 1.f) != 0ull) {
#pragma unroll
                    for (int d = 0; d < 4; ++d)
#pragma unroll
                        for (int i = 0; i < 16; ++i) o[d][i] *= alpha;
                }
            }
            bf16x8 pc0, pc1;
            { const u32x4 w0 = pack8((f32x4){pr[0], pr[1], pr[2], pr[3]}, (f32x4){pr[4], pr[5], pr[6], pr[7]});
              const u32x4 w1 = pack8((f32x4){pr[8], pr[9], pr[10], pr[11]}, (f32x4){pr[12], pr[13], pr[14], pr[15]});
              pc0 = __builtin_bit_cast(bf16x8, w0); pc1 = __builtin_bit_cast(bf16x8, w1); }
            { LAS const unsigned char* vb = buf + voff + kb2 * 64;
#pragma unroll
              for (int d = 0; d < 4; ++d) {
                  const bf16x8 vf0 = *(LAS const bf16x8*)(vb + d * 32 * VP), vf1 = *(LAS const bf16x8*)(vb + d * 32 * VP + 32);
                  o[d] = MFMA32(vf0, pc0, o[d]); o[d] = MFMA32(vf1, pc1, o[d]);
              } }
        }
        if (!FOX) { const int dead = (__builtin_amdgcn_ballot_w64(carry < DEAD) == ~0ull) ? 1 : 0; if (lane == 0) flags[cur * 8 + wave] = dead; }
        if (kt > 0) ATT_STORE(cur ^ 1);
        __syncthreads();
    }
    if (FOX) {
        const float lt = l_run + __shfl_xor(l_run, 32);
        const float inv = 1.f / lt;
#pragma unroll
        for (int d = 0; d < 4; ++d)
#pragma unroll
            for (int i = 0; i < 16; ++i) o[d][i] *= inv;
    }
    { bf16_t* op = Op + (tokbase + myq) * 2048 + h * 128 + 4 * g;
#pragma unroll
      for (int d = 0; d < 4; ++d)
#pragma unroll
          for (int a = 0; a < 4; ++a) {
              u32x2 w; w.x = cvt_pk_bf16(o[d][4 * a], o[d][4 * a + 1]); w.y = cvt_pk_bf16(o[d][4 * a + 2], o[d][4 * a + 3]);
              *(u32x2*)(op + 32 * d + 8 * a) = w;
          } }
#undef ATT_LOAD
#undef ATT_STORE
}
}

namespace peer {
__device__ __forceinline__ unsigned ord_key(float f) { const unsigned u = __builtin_bit_cast(unsigned, f); return (u & 0x80000000u) ? ~u : (u | 0x80000000u); }
__device__ __forceinline__ float ord_val(unsigned k) { const unsigned u = (k & 0x80000000u) ? (k & 0x7fffffffu) : ~k; return __builtin_bit_cast(float, u); }
template <int C> __device__ __forceinline__ unsigned dppu(unsigned v) { return (unsigned)__builtin_amdgcn_update_dpp(0, (int)v, C, 0xF, 0xF, false); }
template <int C> __device__ __forceinline__ float dppf(float v) { return __builtin_bit_cast(float, __builtin_amdgcn_update_dpp(0, __builtin_bit_cast(int, v), C, 0xF, 0xF, false)); }
__device__ __forceinline__ unsigned umax_(unsigned a, unsigned b) { return a > b ? a : b; }
#ifndef PEER_NO_DPP
__device__ __forceinline__ unsigned rowmax_u(unsigned v) { v = umax_(v, dppu<0x128>(v)); v = umax_(v, dppu<0x124>(v)); v = umax_(v, dppu<0x122>(v)); v = umax_(v, dppu<0x121>(v)); return v; }
__device__ __forceinline__ float rowsum_f(float v) { v += dppf<0x128>(v); v += dppf<0x124>(v); v += dppf<0x122>(v); v += dppf<0x121>(v); return v; }
#else
__device__ __forceinline__ unsigned rowmax_u(unsigned v) { v = umax_(v, (unsigned)__shfl_xor((int)v, 8)); v = umax_(v, (unsigned)__shfl_xor((int)v, 4)); v = umax_(v, (unsigned)__shfl_xor((int)v, 2)); v = umax_(v, (unsigned)__shfl_xor((int)v, 1)); return v; }
__device__ __forceinline__ float rowsum_f(float v) { v += __shfl_xor(v, 8); v += __shfl_xor(v, 4); v += __shfl_xor(v, 2); v += __shfl_xor(v, 1); return v; }
#endif

__device__ __forceinline__ float dot8(u32x4 a, u32x4 b, float d) {
#pragma unroll
#ifdef PEER_FDOT2
    for (int t = 0; t < 4; ++t) d = __builtin_amdgcn_fdot2_f32_bf16(__builtin_bit_cast(bf16v2, a[t]), __builtin_bit_cast(bf16v2, b[t]), d, false);
#else
    for (int t = 0; t < 4; ++t) { d += bflo(a[t]) * bflo(b[t]); d += bfhi(a[t]) * bfhi(b[t]); }
#endif
    return d;
}

__device__ __forceinline__ void token(LAS unsigned char* wlds, const bf16_t* __restrict__ SC, const bf16_t* __restrict__ XIN, bf16_t* XN, float* H, const unsigned char* __restrict__ EU, const unsigned char* __restrict__ EV, const float* __restrict__ SU, const float* __restrict__ SV, const float* __restrict__ RS, const int m, const int lane_in, const bool dry = false) {
    int lane = lane_in; asm volatile("" : "+v"(lane));
    LAS int* widx = (LAS int*)wlds;
    LAS float* wgate = (LAS float*)(wlds + 512);
    LAS float* wcoef = (LAS float*)(wlds + 1024);
    const int r = lane >> 4, l16 = lane & 15, pp = r & 1;
#pragma unroll 1
    for (int rd = 0; rd < 4; ++rd) {
        const u32x4 sw = *(const u32x4*)(SC + (size_t)m * 2048 + (4 * rd + r) * 128 + l16 * 8);
        const f32x4 a = {bflo(sw[0]), bfhi(sw[0]), bflo(sw[1]), bfhi(sw[1])}, c = {bflo(sw[2]), bfhi(sw[2]), bflo(sw[3]), bfhi(sw[3])};
        unsigned key[8];
#pragma unroll
        for (int e = 0; e < 4; ++e) { key[e] = (ord_key(a[e]) & ~0xFFu) | (unsigned)(255 - (l16 * 8 + e)); key[4 + e] = (ord_key(c[e]) & ~0xFFu) | (unsigned)(255 - (l16 * 8 + 4 + e)); }
#define PEER_CE(i, j) { const unsigned hi_ = umax_(key[i], key[j]), lo_ = key[i] < key[j] ? key[i] : key[j]; key[i] = hi_; key[j] = lo_; }
        PEER_CE(0, 1) PEER_CE(2, 3) PEER_CE(4, 5) PEER_CE(6, 7) PEER_CE(0, 2) PEER_CE(1, 3) PEER_CE(4, 6) PEER_CE(5, 7) PEER_CE(1, 2) PEER_CE(5, 6) PEER_CE(0, 4) PEER_CE(3, 7)
        PEER_CE(1, 5) PEER_CE(2, 6) PEER_CE(1, 4) PEER_CE(3, 6) PEER_CE(2, 4) PEER_CE(3, 5) PEER_CE(3, 4)
#undef PEER_CE
        unsigned mine = 0u;
#pragma unroll 1
        for (int itn = 0; itn < 16; ++itn) {
            const unsigned rm = rowmax_u(key[0]);
            const bool won = (key[0] == rm);
            mine = (l16 == itn) ? rm : mine;
#pragma unroll
            for (int e = 0; e < 7; ++e) key[e] = won ? key[e + 1] : key[e];
            key[7] = won ? 0u : key[7];
        }
        const float myv = ord_val(mine & ~0xFFu);
        const float s1 = __shfl(myv, (lane & 32) | l16);
        unsigned ck[8];
#pragma unroll
        for (int e = 0; e < 8; ++e) { const float s2 = __shfl(myv, (lane & 32) + 16 + 8 * pp + e); ck[e] = (ord_key(s1 + s2) & ~0xFFu) | (unsigned)(255 - (l16 * 16 + 8 * pp + e)); }
        unsigned sel = 0u;
#pragma unroll 1
        for (int itn = 0; itn < 16; ++itn) {
            unsigned rm = rowmax_u(ck[0]);
            rm = umax_(rm, (unsigned)__shfl_xor((int)rm, 16));
            const bool won = (ck[0] == rm);
            sel = (l16 == itn) ? rm : sel;
#pragma unroll
            for (int e = 0; e < 7; ++e) ck[e] = won ? ck[e + 1] : ck[e];
            ck[7] = won ? 0u : ck[7];
        }
        const float tv = ord_val(sel & ~0xFFu); const int cidx = 255 - (int)(sel & 0xFFu); const int ci = cidx >> 4, cj = cidx & 15;
        const unsigned k1 = (unsigned)__shfl((int)mine, (lane & 32) | ci), k2 = (unsigned)__shfl((int)mine, (lane & 32) + 16 + cj);
        const int expert = (255 - (int)(k1 & 0xFFu)) * 128 + (255 - (int)(k2 & 0xFFu));
        const float mx = ord_val(rowmax_u(sel) & ~0xFFu);
        const float ex = __expf(tv - mx);
        const float gate = ex / rowsum_f(ex);
        if (pp == 0) { const int slot = (2 * rd + (r >> 1)) * 16 + l16; widx[slot] = expert; wgate[slot] = gate; }
    }
    __builtin_amdgcn_wave_barrier(); asm volatile("s_waitcnt lgkmcnt(0)" ::: "memory");
    asm volatile("" : "+v"(lane));
    f32x2 xf[16];
    { const u32x4* xp = (const u32x4*)(XIN + (size_t)m * DM + 32 * lane);
#pragma unroll
      for (int c = 0; c < 4; ++c) { const u32x4 w = xp[c];
#pragma unroll
          for (int t = 0; t < 4; ++t) xf[4 * c + t] = (f32x2){bflo(w[t]), bfhi(w[t])}; } }
#if PEER_FP4
    u32x4 bA[8], bB[8];
#define PEER_LOAD(buf, grp, TABLE) { _Pragma("unroll") for (int e = 0; e < 8; ++e) { const int id = __builtin_amdgcn_readfirstlane(widx[(grp) * 8 + e]); \
        buf[e] = *(const u32x4*)((TABLE) + (size_t)id * ROWB + 16 * lane); } }
#define PEER_DOT(buf, base) { _Pragma("unroll") for (int e = 0; e < 8; ++e) { f32x2 d2 = {0.f, 0.f}; \
        _Pragma("unroll") for (int q = 0; q < 4; ++q) { const unsigned w = buf[e][q]; \
            d2 = d2 + __builtin_amdgcn_cvt_scalef32_pk_f32_fp4(w, 1.0f, 0) * xf[4 * q]; d2 = d2 + __builtin_amdgcn_cvt_scalef32_pk_f32_fp4(w, 1.0f, 1) * xf[4 * q + 1]; \
            d2 = d2 + __builtin_amdgcn_cvt_scalef32_pk_f32_fp4(w, 1.0f, 2) * xf[4 * q + 2]; d2 = d2 + __builtin_amdgcn_cvt_scalef32_pk_f32_fp4(w, 1.0f, 3) * xf[4 * q + 3]; } \
        part[(base) + e] = d2.x + d2.y; } }
#else
    v6u bA[8], bB[8];
#define PEER_LOAD(buf, grp, TABLE) { _Pragma("unroll") for (int e = 0; e < 8; ++e) { const int id = __builtin_amdgcn_readfirstlane(widx[(grp) * 8 + e]); \
        const unsigned char* rp = (TABLE) + (size_t)id * ROWB + 24 * lane; const u32x4 w4 = *(const u32x4*)rp; const u32x2 w2 = *(const u32x2*)(rp + 16); \
        buf[e] = (v6u){w4[0], w4[1], w4[2], w4[3], w2[0], w2[1]}; } }
#define PEER_DOT(buf, base) { _Pragma("unroll") for (int e = 0; e < 8; ++e) { const v32f r = __builtin_amdgcn_cvt_scalef32_pk32_f32_fp6(buf[e], 1.0f); f32x2 d2 = {0.f, 0.f}; \
        _Pragma("unroll") for (int i = 0; i < 16; ++i) d2 = d2 + (f32x2){r[2 * i], r[2 * i + 1]} * xf[i]; part[(base) + e] = d2.x + d2.y; } }
#endif
    const float rstd_in = __builtin_amdgcn_rsqf(RS[m] * (1.f / DM) + EPS);
    PEER_LOAD(bA, 0, EU);
#pragma unroll 1
    for (int hd = 0; hd < 8; ++hd) {
        float part[16];
        const int myid = widx[hd * 16 + (lane & 15)];
        const float su = SU[myid], sv = SV[myid];
        PEER_LOAD(bB, 2 * hd + 1, EU); PEER_DOT(bA, 0); __builtin_amdgcn_sched_barrier(0);
        { const int gn = min(2 * hd + 2, 15); PEER_LOAD(bA, gn, EU); } PEER_DOT(bB, 8); __builtin_amdgcn_sched_barrier(0);
        float r8[8], r4[4], r2[2], r1;
        { const bool b0 = lane & 1;
#pragma unroll
          for (int t = 0; t < 8; ++t) { const float keep = b0 ? part[2 * t + 1] : part[2 * t], send = b0 ? part[2 * t] : part[2 * t + 1]; r8[t] = keep + __shfl_xor(send, 1); } }
        { const bool b1 = lane & 2;
#pragma unroll
          for (int t = 0; t < 4; ++t) { const float keep = b1 ? r8[2 * t + 1] : r8[2 * t], send = b1 ? r8[2 * t] : r8[2 * t + 1]; r4[t] = keep + __shfl_xor(send, 2); } }
        { const bool b2 = lane & 4;
#pragma unroll
          for (int t = 0; t < 2; ++t) { const float keep = b2 ? r4[2 * t + 1] : r4[2 * t], send = b2 ? r4[2 * t] : r4[2 * t + 1]; r2[t] = keep + __shfl_xor(send, 4); } }
        { const bool b3 = lane & 8; const float keep = b3 ? r2[1] : r2[0], send = b3 ? r2[0] : r2[1]; r1 = keep + __shfl_xor(send, 8); }
        r1 += __shfl_xor(r1, 16); r1 += __shfl_xor(r1, 32);
        r1 *= su * rstd_in;
        const float hid = 0.5f * r1 * (1.f + erff(r1 * 0.70710678118654752f));
        if (lane < 16) wcoef[hd * 16 + lane] = wgate[hd * 16 + lane] * hid * sv;
    }
    __builtin_amdgcn_wave_barrier(); asm volatile("s_waitcnt lgkmcnt(0)" ::: "memory");
    asm volatile("" : "+v"(lane));
    f32x2 acc2[16];
#pragma unroll
    for (int i = 0; i < 16; ++i) acc2[i] = (f32x2){0.f, 0.f};
#if PEER_FP4
#define PEER_FMA(buf, grp) { _Pragma("unroll") for (int e = 0; e < 8; ++e) { const float cf = wcoef[(grp) * 8 + e]; const f32x2 cf2 = {cf, cf}; \
        _Pragma("unroll") for (int q = 0; q < 4; ++q) { const unsigned w = buf[e][q]; \
            acc2[4 * q] = acc2[4 * q] + cf2 * __builtin_amdgcn_cvt_scalef32_pk_f32_fp4(w, 1.0f, 0); acc2[4 * q + 1] = acc2[4 * q + 1] + cf2 * __builtin_amdgcn_cvt_scalef32_pk_f32_fp4(w, 1.0f, 1); \
            acc2[4 * q + 2] = acc2[4 * q + 2] + cf2 * __builtin_amdgcn_cvt_scalef32_pk_f32_fp4(w, 1.0f, 2); acc2[4 * q + 3] = acc2[4 * q + 3] + cf2 * __builtin_amdgcn_cvt_scalef32_pk_f32_fp4(w, 1.0f, 3); } } }
#else
#define PEER_FMA(buf, grp) { _Pragma("unroll") for (int e = 0; e < 8; ++e) { const float cf = wcoef[(grp) * 8 + e]; const f32x2 cf2 = {cf, cf}; const v32f r = __builtin_amdgcn_cvt_scalef32_pk32_f32_fp6(buf[e], 1.0f); \
        _Pragma("unroll") for (int i = 0; i < 16; ++i) acc2[i] = acc2[i] + cf2 * (f32x2){r[2 * i], r[2 * i + 1]}; } }
#endif
    PEER_LOAD(bA, 0, EV);
#pragma unroll 1
    for (int gp = 0; gp < 8; ++gp) {
        PEER_LOAD(bB, 2 * gp + 1, EV); PEER_FMA(bA, 2 * gp); __builtin_amdgcn_sched_barrier(0);
        { const int gn = min(2 * gp + 2, 15); PEER_LOAD(bA, gn, EV); } PEER_FMA(bB, 2 * gp + 1); __builtin_amdgcn_sched_barrier(0);
    }
    float ss = 0.f;
    float* hp = H + (size_t)m * DM + 32 * lane;
#pragma unroll
    for (int q = 0; q < 8; ++q) {
        f32x4 h0 = *(const f32x4*)(hp + 4 * q);
        h0[0] += acc2[2 * q].x; h0[1] += acc2[2 * q].y; h0[2] += acc2[2 * q + 1].x; h0[3] += acc2[2 * q + 1].y;
        acc2[2 * q] = (f32x2){h0[0], h0[1]}; acc2[2 * q + 1] = (f32x2){h0[2], h0[3]};
        ss += (h0[0] * h0[0] + h0[1] * h0[1]) + (h0[2] * h0[2] + h0[3] * h0[3]);
        if (!dry || ss == 12345.678f) *(f32x4*)(hp + 4 * q) = h0;
    }
    const float rstd = __builtin_amdgcn_rsqf(wave_sum(ss) * (1.f / DM) + EPS);
    { u32x4* xo = (u32x4*)(XN + (size_t)m * DM + 32 * lane);
#pragma unroll
      for (int c = 0; c < 4; ++c) { u32x4 w;
#pragma unroll
          for (int t = 0; t < 4; ++t) w[t] = cvt_pk_bf16(acc2[4 * c + t].x * rstd, acc2[4 * c + t].y * rstd);
          if (!dry || ss == 12345.678f) xo[c] = w; } }
#undef PEER_LOAD
#undef PEER_DOT
#undef PEER_FMA
}
}


#define XB_TMO      128
#define XB_XCNT(j)  (256  + 64 * (j))
#define XB_XSUB(j)  (1280 + 64 * (j))
#define XB_XGEN(j)  (2304 + 64 * (j))
#define XB_TOP      3328
#define XB_TOPGEN   3392
#define XCD_BAR_WORDS 3456
#define XB_SPIN_CAP (1u << 22)
__device__ __forceinline__ unsigned xb_ld(unsigned* p)              { return __hip_atomic_load(p, __ATOMIC_RELAXED, __HIP_MEMORY_SCOPE_AGENT); }
__device__ __forceinline__ unsigned xb_add(unsigned* p, unsigned v) { return __hip_atomic_fetch_add(p, v, __ATOMIC_RELAXED, __HIP_MEMORY_SCOPE_AGENT); }
__device__ __forceinline__ unsigned xb_xcc_id() { return (unsigned)__builtin_amdgcn_s_getreg((3 << 11) | 20) & 0xFu; }
#define XB_SPIN(cond, bar) do { unsigned _sp = 0; while (cond) { __builtin_amdgcn_s_sleep(1); \
    if ((++_sp & 255u) == 0u) { if (xb_ld(&(bar)[XB_TMO])) break; if (_sp > XB_SPIN_CAP) { atomicAdd(&(bar)[XB_TMO], 1u); break; } } } } while (0)
struct XcdBarrier { unsigned* bar; unsigned x; volatile LAS unsigned* st; };
__device__ __forceinline__ XcdBarrier xcd_barrier_post(unsigned* bar, volatile LAS unsigned* st) {
    XcdBarrier b; b.bar = bar; b.x = xb_xcc_id(); b.st = st;
    if (threadIdx.x == 0) (void)xb_add(&bar[XB_XCNT(b.x)], 1u);
    return b;
}
__device__ __forceinline__ void xcd_barrier_complete(unsigned* bar, unsigned x, unsigned& nloc, unsigned& nx) {
    const unsigned G = gridDim.x * gridDim.y * gridDim.z;
    unsigned sum, cnt, mine, sp = 0u;
    for (;;) {
        sum = 0u; cnt = 0u; mine = 0u;
#pragma unroll
        for (unsigned j = 0; j < 16; ++j) { const unsigned c = xb_ld(&bar[XB_XCNT(j)]); sum += c; cnt += (c > 0u) ? 1u : 0u; mine = (j == x) ? c : mine; }
        if (sum == G) break;
        __builtin_amdgcn_s_sleep(1);
        if ((++sp & 255u) == 0u) { if (xb_ld(&bar[XB_TMO])) break; if (sp > XB_SPIN_CAP) { atomicAdd(&bar[XB_TMO], 1u); break; } }
    }
    nloc = mine > 0u ? mine : 1u; nx = cnt > 0u ? cnt : 1u;
}
__device__ __forceinline__ void xcd_barrier(const XcdBarrier& b) {
    asm volatile("s_waitcnt vmcnt(0)" ::: "memory");
    __syncthreads();
    if (threadIdx.x == 0) {
        unsigned* bar = b.bar;
        __builtin_amdgcn_s_waitcnt(0);
        unsigned nloc = b.st[0], nx = b.st[1];
        if (nloc == 0u) { xcd_barrier_complete(bar, b.x, nloc, nx); b.st[0] = nloc; b.st[1] = nx; }
        const unsigned old = xb_add(&bar[XB_XSUB(b.x)], 1u);
        const unsigned gen = old / nloc;
        if (old + 1u == (gen + 1u) * nloc) {
            __builtin_amdgcn_fence(__ATOMIC_RELEASE, "agent");
            asm volatile("s_waitcnt vmcnt(0)" ::: "memory");
            const unsigned og = xb_add(&bar[XB_TOP], 1u);
            const unsigned tg = og / nx;
            if (og + 1u == (tg + 1u) * nx) xb_add(&bar[XB_TOPGEN], 1u);
            else XB_SPIN(xb_ld(&bar[XB_TOPGEN]) == tg, bar);
            __builtin_amdgcn_fence(__ATOMIC_ACQUIRE, "agent");
            xb_add(&bar[XB_XGEN(b.x)], 1u);
            asm volatile("s_waitcnt vmcnt(0)" ::: "memory");
        } else {
            XB_SPIN(xb_ld(&bar[XB_XGEN(b.x)]) == gen, bar);
            __builtin_amdgcn_fence(__ATOMIC_ACQUIRE, "agent");
            asm volatile("s_waitcnt vmcnt(0)" ::: "memory");
        }
    }
    __syncthreads();
}

constexpr size_t MiB = 1u << 20;
constexpr size_t WS_H = 0;
constexpr size_t WS_XN = 128 * MiB;
constexpr size_t WS_QS = 192 * MiB, WS_KS = 224 * MiB, WS_QF = 256 * MiB, WS_KF = 288 * MiB;
constexpr size_t WS_VTS = 320 * MiB, WS_VTF = 352 * MiB;
constexpr size_t WS_G = 384 * MiB;
constexpr size_t WS_T1 = 512 * MiB;
constexpr size_t WS_PE = 640 * MiB;
constexpr size_t WS_EU = 704 * MiB, WS_EV = 768 * MiB;
constexpr size_t WS_W1T = 832 * MiB;
constexpr size_t WS_WBS = 872 * MiB, WS_WBF = 876 * MiB;
constexpr size_t WS_WOT = 880 * MiB;
constexpr size_t WS_WQB = 888 * MiB;
constexpr size_t WS_WEFF = 896 * MiB;
constexpr size_t WS_WPGT = 904 * MiB;
constexpr size_t WS_WPLT = 912 * MiB;
constexpr size_t WS_SKP = 913 * MiB;
constexpr size_t WS_PB = 914 * MiB;
constexpr size_t WS_LF = 922 * MiB;
constexpr size_t WS_SU = 923 * MiB, WS_SV = WS_SU + 65536;
constexpr size_t WS_OS = 924 * MiB, WS_OF = 956 * MiB;
constexpr size_t WS_CTL = 988 * MiB, CTL_BYTES = 65536;
constexpr size_t WS_RS = 989 * MiB;
constexpr size_t WS_END = 990 * MiB;

struct Args { const float* in[17]; float* out; unsigned char* ws; int ph_lo, ph_hi; };

__device__ __forceinline__ void transpose_item(const float* __restrict__ W, int ldw, int c0, int k0, const float* __restrict__ scale, bf16_t* WT, int ldt, int drow0, LAS float* scr, int lane) {
#pragma unroll 8
    for (int i = 0; i < 32; ++i) { const int kk = 2 * i + (lane >> 5); float v = W[(size_t)(k0 + kk) * ldw + c0 + (lane & 31)]; if (scale) v *= scale[k0 + kk]; scr[kk * 33 + (lane & 31)] = v; }
    asm volatile("s_waitcnt lgkmcnt(0)" ::: "memory");
    const int c = lane & 7;
#pragma unroll
    for (int j = 0; j < 4; ++j) { const int n = (lane >> 3) + 8 * j; const LAS float* s = scr + (8 * c) * 33 + n;
        u32x4 o; o.x = cvt_pk_bf16(s[0 * 33], s[1 * 33]); o.y = cvt_pk_bf16(s[2 * 33], s[3 * 33]); o.z = cvt_pk_bf16(s[4 * 33], s[5 * 33]); o.w = cvt_pk_bf16(s[6 * 33], s[7 * 33]);
        *(u32x4*)(WT + (size_t)(drow0 + n) * ldt + k0 + 8 * c) = o; }
    asm volatile("s_waitcnt lgkmcnt(0)" ::: "memory");
}
__device__ __forceinline__ float fp6_val(int c) { return c < 8 ? 0.125f * c : c < 16 ? 1.f + 0.125f * (c - 8) : c < 24 ? 2.f + 0.25f * (c - 16) : 4.f + 0.5f * (c - 24); }
__device__ __forceinline__ int fp6_code(float v) { return v < 1.f ? (int)(v * 8.f + 0.5f) : v < 2.f ? 8 + (int)((v - 1.f) * 8.f + 0.5f) : v < 4.f ? 16 + (int)((v - 2.f) * 4.f + 0.5f) : 24 + (int)((v - 4.f) * 2.f + 0.5f); }
__device__ __forceinline__ void fp6_probe(LAS int* wl, LAS int* posl) {
    float z = 0.f; asm volatile("" : "+v"(z));
    v16f px, py;
#pragma unroll
    for (int i = 0; i < 16; ++i) { px[i] = fp6_val(i) + z; py[i] = fp6_val(16 + i) + z; }
    const v6u pk = __builtin_amdgcn_cvt_scalef32_2xpk16_fp6_f32(px, py, 1.0f);
    const v32f pr = __builtin_amdgcn_cvt_scalef32_pk32_f32_fp6(pk, 1.0f);
#pragma unroll
    for (int k = 0; k < 32; ++k) wl[fp6_code(pr[k]) & 31] = k;
    asm volatile("s_waitcnt lgkmcnt(0)" ::: "memory");
    (void)posl;
}
__device__ __forceinline__ void quant_row_fp6(const float* __restrict__ src, const float* __restrict__ colscale, unsigned char* dst, float* rscale, int row, int lane, LAS float* stage, LAS const int* pos) {
    const float* rp = src + (size_t)row * DM + 32 * lane;
    f32x4 v[8]; float amax = 0.f;
#pragma unroll
    for (int q = 0; q < 8; ++q) { f32x4 t = *(const f32x4*)(rp + 4 * q); if (colscale) t = t * *(const f32x4*)(colscale + 32 * lane + 4 * q);
        v[q] = t; amax = fmaxf(fmaxf(amax, fmaxf(fabsf(t[0]), fabsf(t[1]))), fmaxf(fabsf(t[2]), fabsf(t[3]))); }
#pragma unroll
    for (int o = 1; o < 64; o <<= 1) amax = fmaxf(amax, __shfl_xor(amax, o));
    const float inv = amax > 0.f ? 7.25f / amax : 0.f;
    LAS float* my = stage + lane * 33;
#pragma unroll
    for (int q = 0; q < 8; ++q) { my[4 * q] = v[q][0] * inv; my[4 * q + 1] = v[q][1] * inv; my[4 * q + 2] = v[q][2] * inv; my[4 * q + 3] = v[q][3] * inv; }
    asm volatile("s_waitcnt lgkmcnt(0)" ::: "memory");
    v16f ex, ey;
#pragma unroll
    for (int j = 0; j < 16; ++j) { ex[j] = my[pos[j]]; ey[j] = my[pos[16 + j]]; }
    asm volatile("s_waitcnt lgkmcnt(0)" ::: "memory");
    const v6u pk = __builtin_amdgcn_cvt_scalef32_2xpk16_fp6_f32(ex, ey, 1.0f);
    u32x2* dp = (u32x2*)(dst + (size_t)row * ROWB + 24 * lane);
    dp[0] = (u32x2){pk[0], pk[1]}; dp[1] = (u32x2){pk[2], pk[3]}; dp[2] = (u32x2){pk[4], pk[5]};
    if (lane == 0) rscale[row] = amax * (1.f / 7.25f);
}
__device__ __forceinline__ void quant_row_fp4(const float* __restrict__ src, const float* __restrict__ colscale, unsigned char* dst, float* rscale, int row, int lane) {
    const float* rp = src + (size_t)row * DM + 32 * lane;
    f32x4 v[8]; float amax = 0.f;
#pragma unroll
    for (int q = 0; q < 8; ++q) { f32x4 t = *(const f32x4*)(rp + 4 * q); if (colscale) t = t * *(const f32x4*)(colscale + 32 * lane + 4 * q);
        v[q] = t; amax = fmaxf(fmaxf(amax, fmaxf(fabsf(t[0]), fabsf(t[1]))), fmaxf(fabsf(t[2]), fabsf(t[3]))); }
#pragma unroll
    for (int o = 1; o < 64; o <<= 1) amax = fmaxf(amax, __shfl_xor(amax, o));
    const float inv = amax > 0.f ? 6.f / amax : 0.f;
    u32x4 w;
#pragma unroll
    for (int q = 0; q < 4; ++q) { const f32x4 a = v[2 * q] * inv, b = v[2 * q + 1] * inv; unsigned p = 0u;
        p = __builtin_amdgcn_cvt_scalef32_pk_fp4_f32(p, a[0], a[1], 1.0f, 0); p = __builtin_amdgcn_cvt_scalef32_pk_fp4_f32(p, a[2], a[3], 1.0f, 1);
        p = __builtin_amdgcn_cvt_scalef32_pk_fp4_f32(p, b[0], b[1], 1.0f, 2); p = __builtin_amdgcn_cvt_scalef32_pk_fp4_f32(p, b[2], b[3], 1.0f, 3); w[q] = p; }
    *(u32x4*)(dst + (size_t)row * ROWB + 16 * lane) = w;
    if (lane == 0) rscale[row] = amax * (1.f / 6.f);
}
__device__ __forceinline__ void convert_flat(const float* __restrict__ src, bf16_t* dst, size_t n8, const float* __restrict__ scale, size_t gt, size_t ngt) {
    for (size_t i = gt; i < n8; i += ngt) {
        f32x4 a = *(const f32x4*)(src + 8 * i), b = *(const f32x4*)(src + 8 * i + 4);
        if (scale) { const int k = (int)((8 * i) & 2047); a = a * *(const f32x4*)(scale + k); b = b * *(const f32x4*)(scale + k + 4); }
        *(u32x4*)(dst + 8 * i) = pack8(a, b);
    }
}

#define PH_BEGIN unsigned char* ws = args.ws; asm volatile("" : "+s"(ws)); int L = Lc; asm volatile("" : "+s"(L)); \
    int tid = threadIdx.x; asm volatile("" : "+v"(tid)); const int lane = tid & 63, wave = __builtin_amdgcn_readfirstlane(tid >> 6); const int G = gridDim.x, bid = blockIdx.x; \
    const int gw = bid * NWAVES + wave, NGW = G * NWAVES; (void)gw; (void)NGW; (void)lane; (void)ws; (void)L;
#define WSP(T, off) ((T*)(ws + (off)))
#define INP(i, stride) (args.in[i] + (size_t)L * (stride))

__device__ __forceinline__ void rms_rows_to_bf16(const float* __restrict__ hsrc, bf16_t* XN, int gw, int NGW, int lane) {
    for (int m = gw; m < M; m += NGW) {
        const float* hr = hsrc + (size_t)m * DM + 4 * lane;
        f32x4 v[8]; float ss = 0.f;
#pragma unroll
        for (int j = 0; j < 8; ++j) { v[j] = *(const f32x4*)(hr + 256 * j); ss += (v[j][0] * v[j][0] + v[j][1] * v[j][1]) + (v[j][2] * v[j][2] + v[j][3] * v[j][3]); }
        const float rstd = __builtin_amdgcn_rsqf(wave_sum(ss) * (1.f / DM) + EPS);
        u32x2* xo = (u32x2*)(XN + (size_t)m * DM) + lane;
#pragma unroll
        for (int j = 0; j < 8; ++j) { v[j] = v[j] * rstd; u32x2 w; w.x = cvt_pk_bf16(v[j][0], v[j][1]); w.y = cvt_pk_bf16(v[j][2], v[j][3]); xo[64 * j] = w; }
    }
}

__global__ void __launch_bounds__(NTHREADS, 2) fwd_kernel(Args args) {
    extern __shared__ __attribute__((aligned(16))) unsigned char lds_raw[];
    LAS unsigned char* lds = (LAS unsigned char*)lds_raw;
    cg::grid_group grid = cg::this_grid();
    const int lo = args.ph_lo, hi = args.ph_hi;
    volatile LAS unsigned* bst = (volatile LAS unsigned*)(lds + LDS_BYTES - 64);
    if (threadIdx.x < 2) bst[threadIdx.x] = 0u;
    __syncthreads();
    const XcdBarrier xbar = xcd_barrier_post((unsigned*)(args.ws + WS_CTL), bst);
#ifndef ONLY_PHASE
#define ONLY_PHASE -1
#endif
#define PH_EN(k) (ONLY_PHASE < 0 || ONLY_PHASE == (k))
#define RUN(p) (lo <= (p) && (p) < hi)
#ifndef REP_SYNC
#define REP_SYNC 1
#endif
#define SEAM(p) do { if ((p) + 1 < hi) { for (int rs_ = 0; rs_ < REP_SYNC; ++rs_) { if (MK_SPLIT == 0 && (p) != 0) xcd_barrier(xbar); else { asm volatile("s_waitcnt vmcnt(0)" ::: "memory"); grid.sync(); } } } } while (0)

#pragma unroll 1
    for (int Lc = 0; Lc < DEPTH; ++Lc) {
        const int P = Lc * 9;

        if (PH_EN(0) && RUN(P + 0)) {
#ifndef REP_P0
#define REP_P0 1
#endif
          for (int rep = 0; rep < REP_P0; ++rep) {
            PH_BEGIN
            const float* g_mix = INP(2, DM); const float* w_in = INP(3, (size_t)DM * INC);
            {
                const float* w_bsb = INP(5, (size_t)1024 * DM); const float* w_bfx = INP(6, (size_t)1024 * DM); const float* w_out = INP(7, (size_t)DM * DM);
                const float* g_ple = INP(13, DM); const float* w_ple = INP(14, (size_t)PLE * DM); const float* w_pg = INP(15, (size_t)DM * DM);
                bf16_t *W1T = WSP(bf16_t, WS_W1T), *WBS = WSP(bf16_t, WS_WBS), *WBF = WSP(bf16_t, WS_WBF), *WOT = WSP(bf16_t, WS_WOT), *WPGT = WSP(bf16_t, WS_WPGT), *WPLT = WSP(bf16_t, WS_WPLT);
                LAS float* scr = (LAS float*)(lds + wave * 16384);
                constexpr int I_IN = 32 * 320, I_B = 16 * 64, I_O = 32 * 64, I_PL = 4 * 64;
                constexpr int NITEMS = I_IN + 2 * I_B + 2 * I_O + I_PL;
                for (int itn = gw; itn < NITEMS; itn += NGW) {
                    int r = itn;
                    if (r < I_IN) { const int kb = r / 320, nb = r % 320, n0 = 32 * nb; transpose_item(w_in, INC, n0 + (n0 >= 6144 ? 8 : 0), 64 * kb, g_mix, W1T, DM, n0, scr, lane); continue; } r -= I_IN;
                    if (r < I_B) { const int kb = r / 64, nb = r % 64; transpose_item(w_bsb, DM, 32 * nb, 64 * kb, nullptr, WBS, 2048, 32 * nb, scr, lane); continue; } r -= I_B;
                    if (r < I_B) { const int kb = r / 64, nb = r % 64; transpose_item(w_bfx, DM, 32 * nb, 64 * kb, nullptr, WBS + 1024, 2048, 32 * nb, scr, lane); continue; } r -= I_B;
                    if (r < I_O) { const int kb = r / 64, nb = r % 64; transpose_item(w_out, DM, 32 * nb, 64 * kb, nullptr, WOT, DM, 32 * nb, scr, lane); continue; } r -= I_O;
                    if (r < I_O) { const int kb = r / 64, nb = r % 64; transpose_item(w_pg, DM, 32 * nb, 64 * kb, g_ple, WPGT, DM, 32 * nb, scr, lane); continue; } r -= I_O;
                    { const int kb = r / 64, nb = r % 64; transpose_item(w_ple, DM, 32 * nb, 64 * kb, nullptr, WPLT, PLE, 32 * nb, scr, lane); }
                }
            }
            {
                const float* g_ffn = INP(8, DM); const float* sub_keys = INP(10, (size_t)16 * 128 * 128);
                bf16_t* SKP = WSP(bf16_t, WS_SKP);
                const size_t gt = (size_t)bid * NTHREADS + tid, ngt = (size_t)G * NTHREADS;
                convert_flat(INP(9, (size_t)DM * DM), WSP(bf16_t, WS_WQB), (size_t)DM * DM / 8, nullptr, gt, ngt);
                { const float* eu = INP(11, (size_t)NEXP * DM); const float* ev = INP(12, (size_t)NEXP * DM);
#if PEER_FP4
                  for (int rr = gw; rr < 2 * NEXP; rr += NGW) { if (rr < NEXP) quant_row_fp4(eu, g_ffn, WSP(unsigned char, WS_EU), WSP(float, WS_SU), rr, lane); else quant_row_fp4(ev, nullptr, WSP(unsigned char, WS_EV), WSP(float, WS_SV), rr - NEXP, lane); } }
#else
                  LAS float* stage = (LAS float*)(lds + wave * 16384); LAS int* pos = (LAS int*)(lds + wave * 16384 + 8704); fp6_probe(pos, pos);
                  for (int rr = gw; rr < 2 * NEXP; rr += NGW) { if (rr < NEXP) quant_row_fp6(eu, g_ffn, WSP(unsigned char, WS_EU), WSP(float, WS_SU), rr, lane, stage, pos); else quant_row_fp6(ev, nullptr, WSP(unsigned char, WS_EV), WSP(float, WS_SV), rr - NEXP, lane, stage, pos); } }
#endif
                convert_flat(INP(1, (size_t)M * PLE), WSP(bf16_t, WS_PB), (size_t)M * PLE / 8, nullptr, gt, ngt);
                for (size_t i = gt; i < (size_t)M; i += ngt) WSP(float, WS_RS)[i] = 0.f;
                for (size_t i = gt; i < (size_t)2048 * 256 / 8; i += ngt) {
                    const int n = (int)(i >> 5), c8 = (int)(i & 31) * 8, pp = (n >> 7) & 1;
                    u32x4 o = {0u, 0u, 0u, 0u};
                    if ((c8 >> 7) == pp) { const float* sp = sub_keys + (size_t)n * 128 + (c8 & 127); o = pack8(*(const f32x4*)sp, *(const f32x4*)(sp + 4)); }
                    *(u32x4*)(SKP + (size_t)n * 256 + c8) = o;
                }
            }
            __syncthreads();
            {
                const float* h_in = (L == 0) ? args.in[0] : WSP(const float, WS_H);
                const float* b_f = INP(4, NH);
                bf16_t* XN = WSP(bf16_t, WS_XN); float* LF = WSP(float, WS_LF);
                LAS float* WF = (LAS float*)lds;
                for (int i = tid; i < 8 * DM; i += NTHREADS) { const int k = i >> 3, j = i & 7; WF[j * DM + k] = w_in[(size_t)k * INC + 6144 + j] * g_mix[k]; }
                __syncthreads();
                for (int m = gw; m < M; m += NGW) {
                    const float* hr = h_in + (size_t)m * DM + 4 * lane;
                    f32x4 v[8]; float ss = 0.f;
#pragma unroll
                    for (int j = 0; j < 8; ++j) { v[j] = *(const f32x4*)(hr + 256 * j); ss += (v[j][0] * v[j][0] + v[j][1] * v[j][1]) + (v[j][2] * v[j][2] + v[j][3] * v[j][3]); }
                    const float rstd = __builtin_amdgcn_rsqf(wave_sum(ss) * (1.f / DM) + EPS);
                    u32x2* xo = (u32x2*)(XN + (size_t)m * DM) + lane;
#pragma unroll
                    for (int j = 0; j < 8; ++j) { v[j] = v[j] * rstd; u32x2 w; w.x = cvt_pk_bf16(v[j][0], v[j][1]); w.y = cvt_pk_bf16(v[j][2], v[j][3]); xo[64 * j] = w; }
                    float myf = 0.f;
#pragma unroll
                    for (int hh = 0; hh < 8; ++hh) {
                        float d = 0.f;
#pragma unroll
                        for (int j = 0; j < 8; ++j) { const f32x4 w = *(const LAS f32x4*)(WF + hh * DM + 256 * j + 4 * lane); d += (v[j][0] * w[0] + v[j][1] * w[1]) + (v[j][2] * w[2] + v[j][3] * w[3]); }
                        d = wave_sum(d);
                        myf = (lane == hh) ? d : myf;
                    }
                    if (lane < 8) {
                        const float xx = myf + b_f[lane];
                        const float ls = fminf(xx, 0.f) - log1pf(__expf(-fabsf(xx)));
                        LF[(size_t)((m >> 12) * 8 + lane) * SEQ + (m & 4095)] = ls * LOG2E;
                    }
                }
            }
            __syncthreads();
          }
            SEAM(P + 0);
        }

        if (PH_EN(1) && RUN(P + 1)) {
#ifndef REP_P1
#define REP_P1 1
#endif
          for (int rep = 0; rep < REP_P1; ++rep) {
            { PH_BEGIN
              pg8::SchedSimple S; S.t.init(M / 256, 10240 / 256, G, bid); S.A = (const char*)WSP(bf16_t, WS_XN); S.B = (const char*)WSP(bf16_t, WS_W1T); S.astride = (size_t)256 * DM * 2; S.bstride = (size_t)256 * DM * 2;
              pg8::Epi1 E{WSP(bf16_t, WS_QS), WSP(bf16_t, WS_KS), WSP(bf16_t, WS_QF), WSP(bf16_t, WS_KF), WSP(bf16_t, WS_VTS), WSP(bf16_t, WS_VTF), WSP(bf16_t, WS_G)};
              pg8::gemm_phase(lds, DM, DM, DM, S, E); }
            { PH_BEGIN
              pg8::SchedWeff S; S.t.init(8, 8, G, bid); S.A = (const char*)WSP(bf16_t, WS_SKP); S.B = (const char*)WSP(bf16_t, WS_WQB); S.astride = (size_t)256 * 256 * 2; S.bstride = (size_t)256 * DM * 2;
              pg8::EpiWeff E{WSP(bf16_t, WS_WEFF), INP(8, DM)};
              pg8::gemm_phase(lds, 256, DM, 256, S, E); }
            { PH_BEGIN
              pg8::SchedSimple S; S.t.init(M / 256, 8, G, bid); S.A = (const char*)WSP(bf16_t, WS_PB); S.B = (const char*)WSP(bf16_t, WS_WPLT); S.astride = (size_t)256 * PLE * 2; S.bstride = (size_t)256 * PLE * 2;
              pg8::EpiBf16Plain E{WSP(bf16_t, WS_PE), DM};
              pg8::gemm_phase(lds, PLE, PLE, PLE, S, E); }
          }
            SEAM(P + 1);
        }

        if (PH_EN(2) && RUN(P + 2)) {
#ifndef REP_ATT
#define REP_ATT 1
#endif
          for (int rep = 0; rep < REP_ATT; ++rep) {
            { PH_BEGIN
              bf16_t *QF = WSP(bf16_t, WS_QF), *KF = WSP(bf16_t, WS_KF), *VTF = WSP(bf16_t, WS_VTF), *OF = WSP(bf16_t, WS_OS) + 1024; const float* LF = WSP(const float, WS_LF);
              for (int w = bid; w < 256; w += G) {
                  const int bh = w >> 3, j = w & 7;
                  att::item<true>(lds, QF, KF, VTF, OF, LF, bh >> 3, bh & 7, 15 - j);
                  att::item<true>(lds, QF, KF, VTF, OF, LF, bh >> 3, bh & 7, j);
              } }
            { PH_BEGIN
              bf16_t *QS = WSP(bf16_t, WS_QS), *KS = WSP(bf16_t, WS_KS), *VTS = WSP(bf16_t, WS_VTS), *OS = WSP(bf16_t, WS_OS);
              for (int w = bid; w < 512; w += G) {
                  const int bh = w >> 4, qb = w & 15;
                  att::item<false>(lds, QS, KS, VTS, OS, nullptr, bh >> 3, bh & 7, qb);
              } }
          }
            SEAM(P + 2);
        }

        if (PH_EN(3) && RUN(P + 3)) {
#ifndef REP_P3
#define REP_P3 1
#endif
          for (int rep = 0; rep < REP_P3; ++rep) {
            PH_BEGIN
            pg8::SchedSimple S; S.t.init(M / 256, 8, G, bid); S.A = (const char*)WSP(bf16_t, WS_OS); S.B = (const char*)WSP(bf16_t, WS_WBS); S.astride = (size_t)256 * DM * 2; S.bstride = (size_t)256 * DM * 2;
            pg8::Epi2 E{WSP(bf16_t, WS_G), WSP(bf16_t, WS_XN)};
            pg8::gemm_phase<pg8::Epi2, pg8::SchedSimple, true>(lds, DM, DM, DM, S, E);
          }
            SEAM(P + 3);
        }

        if (PH_EN(4) && RUN(P + 4)) {
            PH_BEGIN
            pg8::SchedSimple S; S.t.init(M / 256, 8, G, bid); S.A = (const char*)WSP(bf16_t, WS_XN); S.B = (const char*)WSP(bf16_t, WS_WOT); S.astride = (size_t)256 * DM * 2; S.bstride = (size_t)256 * DM * 2;
            pg8::Epi3 E{(L == 0) ? args.in[0] : WSP(const float, WS_H), WSP(float, WS_H), WSP(bf16_t, WS_QS)  , WSP(float, WS_RS)};
            pg8::gemm_phase(lds, DM, DM, DM, S, E);
            SEAM(P + 4);
        }


        if (PH_EN(6) && RUN(P + 6)) {
#ifndef REP_P6
#define REP_P6 1
#endif
          for (int rep = 0; rep < REP_P6; ++rep) {
            PH_BEGIN
            pg8::SchedSimple S; S.t.init(M / 256, 8, G, bid); S.A = (const char*)WSP(bf16_t, WS_QS); S.B = (const char*)WSP(bf16_t, WS_WEFF); S.astride = (size_t)256 * DM * 2; S.bstride = (size_t)256 * DM * 2;
            pg8::EpiF32 E{WSP(bf16_t, WS_T1), WSP(const float, WS_RS)};
            pg8::gemm_phase(lds, DM, DM, DM, S, E);
          }
            SEAM(P + 6);
        }

        if (PH_EN(7) && RUN(P + 7)) {
            PH_BEGIN
            LAS unsigned char* wl = lds + wave * 2048;
            const bf16_t* T1 = WSP(const bf16_t, WS_T1); bf16_t* XN = WSP(bf16_t, WS_XN); const bf16_t* XIN = WSP(const bf16_t, WS_QS); float* HB = WSP(float, WS_H); const unsigned char *EU = WSP(const unsigned char, WS_EU), *EV = WSP(const unsigned char, WS_EV); const float *SU = WSP(const float, WS_SU), *SV = WSP(const float, WS_SV), *RS = WSP(const float, WS_RS);
#ifdef REP_PEER
            for (int m = gw; m < M; m += NGW) peer::token(wl, T1, XIN, XN, HB, EU, EV, SU, SV, RS, m, lane, true);
#endif
            for (int m = gw; m < M; m += NGW) peer::token(wl, T1, XIN, XN, HB, EU, EV, SU, SV, RS, m, lane);
            SEAM(P + 7);
        }

        if (PH_EN(8) && RUN(P + 8)) {
            PH_BEGIN
            pg8::SchedSimple S; S.t.init(M / 256, 8, G, bid); S.A = (const char*)WSP(bf16_t, WS_XN); S.B = (const char*)WSP(bf16_t, WS_WPGT); S.astride = (size_t)256 * DM * 2; S.bstride = (size_t)256 * DM * 2;
            pg8::Epi10 E{WSP(float, WS_H), WSP(const bf16_t, WS_PE)};
            pg8::gemm_phase(lds, DM, DM, DM, S, E);
            SEAM(P + 8);
        }
    }
    if (PH_EN(9) && RUN(DEPTH * 9)) {
        const int Lc = 0;
        PH_BEGIN
        const float* gfin = args.in[16]; const float* HB = WSP(const float, WS_H);
        for (int m = gw; m < M; m += NGW) {
            const float* hr = HB + (size_t)m * DM + 4 * lane;
            f32x4 v[8]; float ss = 0.f;
#pragma unroll
            for (int j = 0; j < 8; ++j) { v[j] = *(const f32x4*)(hr + 256 * j); ss += (v[j][0] * v[j][0] + v[j][1] * v[j][1]) + (v[j][2] * v[j][2] + v[j][3] * v[j][3]); }
            const float rstd = __builtin_amdgcn_rsqf(wave_sum(ss) * (1.f / DM) + EPS);
            float* op = args.out + (size_t)m * DM + 4 * lane;
#pragma unroll
            for (int j = 0; j < 8; ++j) { const f32x4 gg = *(const f32x4*)(gfin + 256 * j + 4 * lane); *(f32x4*)(op + 256 * j) = v[j] * rstd * gg; }
        }
    }
#undef RUN
#undef SEAM
}

extern "C" void kernel_launch(void* const* d_in, const int* in_sizes, int n_in, void* d_out, int out_size, void* d_ws, size_t ws_size, hipStream_t stream) {
    static int grid = 0;
    if (grid == 0) {
        if (n_in != 17 || out_size != M * DM || ws_size < WS_END) { fprintf(stderr, "kernel_launch: unexpected problem (n_in %d, out %d, ws %zu)\n", n_in, out_size, ws_size); grid = -1; return; }
        int dev = 0, cus = 0, per_cu = 0;
        hipGetDevice(&dev); hipDeviceGetAttribute(&cus, hipDeviceAttributeMultiprocessorCount, dev);
        if (hipFuncSetAttribute((const void*)fwd_kernel, hipFuncAttributeMaxDynamicSharedMemorySize, LDS_BYTES) != hipSuccess) { fprintf(stderr, "kernel_launch: hipFuncSetAttribute failed\n"); grid = -1; return; }
        if (hipOccupancyMaxActiveBlocksPerMultiprocessor(&per_cu, (const void*)fwd_kernel, NTHREADS, LDS_BYTES) != hipSuccess || per_cu < 1) { fprintf(stderr, "kernel_launch: occupancy query says %d blocks per CU\n", per_cu); per_cu = 1; }
        (void)hipGetLastError();
        grid = cus * per_cu;
        fprintf(stderr, "kernel_launch: grid %d (cus %d x %d)\n", grid, cus, per_cu);
    }
    if (grid < 0) return;
    Args a{};
    for (int i = 0; i < 17; ++i) a.in[i] = (const float*)d_in[i];
    a.out = (float*)d_out; a.ws = (unsigned char*)d_ws;
    constexpr int NPH = DEPTH * 9 + 1;
    if (hipMemsetAsync((char*)d_ws + WS_CTL, 0, CTL_BYTES, stream) != hipSuccess) { fprintf(stderr, "kernel_launch: memset of the barrier words failed\n"); return; }
#if MK_SPLIT
    for (int p = 0; p < NPH; ++p) { a.ph_lo = p; a.ph_hi = p + 1; hipLaunchKernelGGL(fwd_kernel, dim3(grid), dim3(NTHREADS), LDS_BYTES, stream, a); }
#else
    a.ph_lo = 0; a.ph_hi = NPH;
    void* kargs[] = {&a};
    hipError_t e = hipLaunchCooperativeKernel((const void*)fwd_kernel, dim3(grid), dim3(NTHREADS), kargs, LDS_BYTES, stream);
    if (e != hipSuccess) fprintf(stderr, "kernel_launch: cooperative launch failed: %s (grid %d)\n", hipGetErrorString(e), grid);
#endif
}
```
